# Optimizing an MI355X kernel written in HIP

```python
import jax, jax.numpy as jnp
from jax import lax
import numpy as np

D_MODEL = 2048
BATCH = 4
SEQ = 2048
DEPTH = 2

EPS = 1e-6
NEG = -1e30
HEAD_DIM = 128
ROT_DIM = HEAD_DIM // 4
ROPE_THETA = 500000.0
DILATED_PATTERNS = ((128, 1), (512, 4), (2048, 16))
ATT_GROUPS = len(DILATED_PATTERNS)
HEADS_PER_GROUP = D_MODEL // (2 * HEAD_DIM)
ATT_QKV = ATT_GROUPS * HEADS_PER_GROUP * HEAD_DIM
ATT_OUT = HEADS_PER_GROUP * HEAD_DIM
POOL_WINDOWS = (2, 4, 8, 16)
POOL_GROUPS = len(POOL_WINDOWS)
POOL_WIDTH = D_MODEL // 2
POOL_CH = POOL_WIDTH // POOL_GROUPS
SGU_WIDTH = D_MODEL // 2
SGU_GROUPS = 4
SGU_CH = SGU_WIDTH // SGU_GROUPS
CHUNK = 128
CONV_WIDTH = D_MODEL // 2
CONV_K = 31
EVEN_COLS = (POOL_WIDTH, POOL_WIDTH, ATT_QKV, ATT_QKV, ATT_QKV, ATT_OUT)
ODD_COLS = (SGU_WIDTH, SGU_WIDTH, SGU_WIDTH, CONV_WIDTH, CONV_WIDTH, CONV_WIDTH)
EVEN_IN = sum(EVEN_COLS)
ODD_IN = sum(ODD_COLS)
MIX_OUT = POOL_WIDTH + ATT_OUT
N_EVEN = (DEPTH + 1) // 2
N_ODD = DEPTH // 2

kernel_name = "hybrid_pool_dilattn_sgu_conv"


def _split_points(cols):
    return [int(c) for c in np.cumsum(cols)[:-1]]


def rmsnorm(x, g):
    xf = x.astype(jnp.float32)
    y = xf * lax.rsqrt(jnp.mean(xf * xf, axis=-1, keepdims=True) + EPS) * g.astype(jnp.float32)
    return y.astype(x.dtype)


def layernorm(x, g, b):
    xf = x.astype(jnp.float32)
    mu = jnp.mean(xf, axis=-1, keepdims=True)
    var = jnp.mean(jnp.square(xf - mu), axis=-1, keepdims=True)
    y = (xf - mu) * lax.rsqrt(var + EPS) * g.astype(jnp.float32) + b.astype(jnp.float32)
    return y.astype(x.dtype)


def partial_rope(t, cos, sin):
    tf = t.astype(jnp.float32)
    half = ROT_DIM // 2
    t1, t2 = tf[..., :half], tf[..., half:ROT_DIM]
    c, s = cos[None, :, None, :], sin[None, :, None, :]
    out = jnp.concatenate([t1 * c - t2 * s, t2 * c + t1 * s, tf[..., ROT_DIM:]], axis=-1)
    return out.astype(t.dtype)


def causal_pool_mixer(xa, pool_w, pool_scale):
    B, S, _ = xa.shape
    xg = xa.reshape(B, S, POOL_GROUPS, POOL_CH).astype(jnp.float32)
    csp = jnp.concatenate([jnp.zeros((B, 1, POOL_GROUPS, POOL_CH), jnp.float32),
                           jnp.cumsum(xg, axis=1)], axis=1)
    t = jnp.arange(S)
    outs = []
    for g, w in enumerate(POOL_WINDOWS):
        upper = csp[:, 1:, g]
        lower = jnp.concatenate([jnp.zeros((B, w - 1, POOL_CH), jnp.float32),
                                 csp[:, :S + 1 - w, g]], axis=1)
        count = jnp.minimum(t + 1, w).astype(jnp.float32)[None, :, None]
        outs.append((upper - lower) / count - xg[:, :, g])
    pooled = jnp.stack(outs, axis=2).astype(xa.dtype)
    mixed = jnp.einsum('bsgc,gcd->bsgd', pooled, pool_w)
    return mixed.reshape(B, S, POOL_WIDTH) * pool_scale


def dilated_group(q, k, v, dilation, span):
    B, S, H, E = q.shape
    L = S // dilation
    nb = -(-L // span)
    Lp = nb * span

    def to_blocks(t):
        t = t.reshape(B, L, dilation, H, E)
        t = jnp.pad(t, ((0, 0), (0, Lp - L), (0, 0), (0, 0), (0, 0)))
        return t.reshape(B, nb, span, dilation, H, E)

    def with_prev(t):
        prev = jnp.pad(t, ((0, 0), (1, 0), (0, 0), (0, 0), (0, 0), (0, 0)))[:, :-1]
        return jnp.concatenate([prev, t], axis=2)

    qb = to_blocks(q)
    kk = with_prev(to_blocks(k))
    vv = with_prev(to_blocks(v))
    s = jnp.einsum('bnqrhe,bnkrhe->bnrhqk', qb, kk,
                   preferred_element_type=jnp.float32) * (HEAD_DIM ** -0.5)
    qi = jnp.arange(span)[:, None]
    kj = jnp.arange(2 * span)[None, :] - span
    dist = qi - kj
    blk = jnp.arange(nb)[:, None, None]
    valid = (dist >= 0)[None] & (dist <= span)[None] & (blk * span + kj[None] >= 0)
    s = jnp.where(valid[None, :, None, None], s, NEG)
    m = jnp.max(s, axis=-1, keepdims=True)
    p = jnp.exp(s - m)
    den = jnp.sum(p, axis=-1)
    o = jnp.einsum('bnrhqk,bnkrhe->bnqrhe', p.astype(vv.dtype), vv,
                   preferred_element_type=jnp.float32)
    den_t = jnp.transpose(den, (0, 1, 4, 2, 3))
    o = o / den_t[..., None]
    lse = jnp.transpose(m[..., 0], (0, 1, 4, 2, 3)) + jnp.log(den_t)
    o = o.reshape(B, Lp, dilation, H, E)[:, :L].reshape(B, S, H, E)
    lse = lse.reshape(B, Lp, dilation, H)[:, :L].reshape(B, S, H)
    return o, lse


def dilated_attention(q, k, v, cos, sin):
    B, S, _ = q.shape
    shp = (B, S, ATT_GROUPS * HEADS_PER_GROUP, HEAD_DIM)
    q = partial_rope(q.reshape(shp), cos, sin).reshape(B, S, ATT_GROUPS, HEADS_PER_GROUP, HEAD_DIM)
    k = partial_rope(k.reshape(shp), cos, sin).reshape(B, S, ATT_GROUPS, HEADS_PER_GROUP, HEAD_DIM)
    v = v.reshape(B, S, ATT_GROUPS, HEADS_PER_GROUP, HEAD_DIM)
    outs, lses = [], []
    for g, (window, dilation) in enumerate(DILATED_PATTERNS):
        o_g, lse_g = dilated_group(q[:, :, g], k[:, :, g], v[:, :, g], dilation, window // dilation)
        outs.append(o_g)
        lses.append(lse_g)
    wts = jax.nn.softmax(jnp.stack(lses, axis=0), axis=0)
    o = jnp.sum(wts[..., None] * jnp.stack(outs, axis=0), axis=0)
    return o.reshape(B, S, ATT_OUT).astype(q.dtype)


def chunked_sgu(u, v, g, b, w_s, b_s):
    B, S, _ = v.shape
    vn = layernorm(v, g, b).reshape(B, S // CHUNK, CHUNK, SGU_GROUPS, SGU_CH)
    mask = jnp.tril(jnp.ones((CHUNK, CHUNK), w_s.dtype))
    s = jnp.einsum('hij,bnjhc->bnihc', w_s * mask[None], vn) + b_s.T[None, None, :, :, None]
    return u * s.reshape(B, S, SGU_WIDTH)


def causal_depthwise_conv(x, w, b):
    out = lax.conv_general_dilated(x, w[:, None, :].astype(x.dtype), window_strides=(1,),
                                   padding=[(CONV_K - 1, 0)],
                                   dimension_numbers=('NWC', 'WIO', 'NWC'),
                                   feature_group_count=x.shape[-1])
    return out + b


def even_mixer(h, w_in, pool_w, pool_scale, w_out, cos, sin):
    z = h @ w_in
    a_in, a_gate, q, k, v, b_gate = jnp.split(z, _split_points(EVEN_COLS), axis=-1)
    ya = causal_pool_mixer(a_in, pool_w, pool_scale) * jax.nn.silu(a_gate)
    yb = dilated_attention(q, k, v, cos, sin) * jax.nn.silu(b_gate)
    return jnp.concatenate([ya, yb], axis=-1) @ w_out


def odd_mixer(h, w_in, sgu_g, sgu_b, sgu_w, sgu_bias, conv_w, conv_b, cn_g, cn_b, w_out):
    z = h @ w_in
    u, v, c_gate, d_val, d_glu, d_gate = jnp.split(z, _split_points(ODD_COLS), axis=-1)
    yc = chunked_sgu(u, v, sgu_g, sgu_b, sgu_w, sgu_bias) * jax.nn.silu(c_gate)
    d = d_val * jax.nn.sigmoid(d_glu)
    d = causal_depthwise_conv(d, conv_w, conv_b)
    d = jax.nn.silu(layernorm(d, cn_g, cn_b))
    yd = d * jax.nn.silu(d_gate)
    return jnp.concatenate([yc, yd], axis=-1) @ w_out


def setup_inputs(seed: int = 0) -> dict:
    key = jax.random.key(seed)
    ks = jax.random.split(key, 20)
    f32 = jnp.float32

    def nrm(k, shape, scale):
        return jax.random.normal(k, shape, f32) * scale

    def gain(k, shape):
        return 1.0 + 0.05 * jax.random.normal(k, shape, f32)

    return {
        "x": jax.random.normal(ks[0], (BATCH, SEQ, D_MODEL), f32),
        "e_pre_norm": gain(ks[1], (N_EVEN, D_MODEL)),
        "e_w_in": nrm(ks[2], (N_EVEN, D_MODEL, EVEN_IN), D_MODEL ** -0.5),
        "e_pool_w": nrm(ks[3], (N_EVEN, POOL_GROUPS, POOL_CH, POOL_CH), POOL_CH ** -0.5),
        "e_pool_scale": gain(ks[4], (N_EVEN, POOL_WIDTH)),
        "e_w_out": nrm(ks[5], (N_EVEN, MIX_OUT, D_MODEL), MIX_OUT ** -0.5),
        "e_post_norm": gain(ks[6], (N_EVEN, D_MODEL)),
        "o_pre_norm": gain(ks[7], (N_ODD, D_MODEL)),
        "o_w_in": nrm(ks[8], (N_ODD, D_MODEL, ODD_IN), D_MODEL ** -0.5),
        "o_sgu_norm_g": gain(ks[9], (N_ODD, SGU_WIDTH)),
        "o_sgu_norm_b": nrm(ks[10], (N_ODD, SGU_WIDTH), 0.02),
        "o_sgu_w": nrm(ks[11], (N_ODD, SGU_GROUPS, CHUNK, CHUNK), CHUNK ** -0.5),
        "o_sgu_b": gain(ks[12], (N_ODD, SGU_GROUPS, CHUNK)),
        "o_conv_w": nrm(ks[13], (N_ODD, CONV_K, CONV_WIDTH), CONV_K ** -0.5),
        "o_conv_b": nrm(ks[14], (N_ODD, CONV_WIDTH), 0.02),
        "o_conv_norm_g": gain(ks[15], (N_ODD, CONV_WIDTH)),
        "o_conv_norm_b": nrm(ks[16], (N_ODD, CONV_WIDTH), 0.02),
        "o_w_out": nrm(ks[17], (N_ODD, MIX_OUT, D_MODEL), MIX_OUT ** -0.5),
        "o_post_norm": gain(ks[18], (N_ODD, D_MODEL)),
    }


def reference(x, e_pre_norm, e_w_in, e_pool_w, e_pool_scale, e_w_out, e_post_norm,
              o_pre_norm, o_w_in, o_sgu_norm_g, o_sgu_norm_b, o_sgu_w, o_sgu_b,
              o_conv_w, o_conv_b, o_conv_norm_g, o_conv_norm_b, o_w_out, o_post_norm):
    S = x.shape[1]
    pos = jnp.arange(S, dtype=jnp.float32)
    inv_freq = jnp.power(ROPE_THETA, -jnp.arange(0, ROT_DIM, 2, dtype=jnp.float32) / ROT_DIM)
    ang = pos[:, None] * inv_freq[None, :]
    cos, sin = jnp.cos(ang), jnp.sin(ang)
    for i in range(DEPTH):
        j = i // 2
        if i % 2 == 0:
            h = rmsnorm(x, e_pre_norm[j])
            y = even_mixer(h, e_w_in[j], e_pool_w[j], e_pool_scale[j], e_w_out[j], cos, sin)
            x = x + rmsnorm(y, e_post_norm[j])
        else:
            h = rmsnorm(x, o_pre_norm[j])
            y = odd_mixer(h, o_w_in[j], o_sgu_norm_g[j], o_sgu_norm_b[j], o_sgu_w[j], o_sgu_b[j],
                          o_conv_w[j], o_conv_b[j], o_conv_norm_g[j], o_conv_norm_b[j], o_w_out[j])
            x = x + rmsnorm(y, o_post_norm[j])
    return x
```

```cpp
#include <hip/hip_runtime.h>
#include <cstdio>
#include <cstdint>

#ifndef MK_N_LAUNCHES
#define MK_N_LAUNCHES 1
#endif

#ifndef REP0
#define REP0 1
#endif
#ifndef REP1
#define REP1 1
#endif
#ifndef REP2
#define REP2 1
#endif
#ifndef REP3
#define REP3 1
#endif
#ifndef REP4
#define REP4 1
#endif
#ifndef REP5
#define REP5 1
#endif
#ifndef REP6
#define REP6 1
#endif
#ifndef REP7
#define REP7 1
#endif
#ifndef REP8
#define REP8 1
#endif
#ifndef XSYNC
#define XSYNC 0
#endif
#ifndef SGU_TPS
#define SGU_TPS 2
#endif
#define LAS __attribute__((address_space(3)))
typedef unsigned short bf16;
typedef short bf16x8 __attribute__((ext_vector_type(8)));
typedef float f32x4 __attribute__((ext_vector_type(4)));
typedef float f32x2 __attribute__((ext_vector_type(2)));
typedef unsigned v4u __attribute__((ext_vector_type(4)));
typedef unsigned v2u __attribute__((ext_vector_type(2)));

__device__ __forceinline__ unsigned cvt_pk_bf16(float lo, float hi) { unsigned r; asm volatile("v_cvt_pk_bf16_f32 %0, %1, %2" : "=v"(r) : "v"(lo), "v"(hi)); return r; }
__device__ __forceinline__ float bflo(unsigned u) { return __uint_as_float(u << 16); }
__device__ __forceinline__ float bfhi(unsigned u) { return __uint_as_float(u & 0xffff0000u); }
__device__ __forceinline__ float silu_f(float x) { return x / (1.f + __expf(-x)); }
__device__ __forceinline__ float sigmoid_f(float x) { return 1.f / (1.f + __expf(-x)); }
#define DPP_ADD(v, ctrl) ((v) + __builtin_bit_cast(float, __builtin_amdgcn_update_dpp(0, __builtin_bit_cast(int, (v)), (ctrl), 0xF, 0xF, true)))
__device__ __forceinline__ float row_sum16(float v) {
    v = DPP_ADD(v, 0xB1); v = DPP_ADD(v, 0x4E); v = DPP_ADD(v, 0x141); v = DPP_ADD(v, 0x140); return v;
}
__device__ __forceinline__ float rdlane(float v, int l) { return __builtin_bit_cast(float, __builtin_amdgcn_readlane(__builtin_bit_cast(int, v), l)); }
__device__ __forceinline__ float wave_sum(float v) { v = row_sum16(v); return (rdlane(v, 0) + rdlane(v, 16)) + (rdlane(v, 32) + rdlane(v, 48)); }
__device__ __forceinline__ float lane_xor32(float v, int lane) { const auto r = __builtin_amdgcn_permlane32_swap(__builtin_bit_cast(unsigned, v), __builtin_bit_cast(unsigned, v), false, false); return __builtin_bit_cast(float, (lane & 32) ? r[0] : r[1]); }
__device__ __forceinline__ float lane_xor16(float v, int lane) { const auto r = __builtin_amdgcn_permlane16_swap(__builtin_bit_cast(unsigned, v), __builtin_bit_cast(unsigned, v), false, false); return __builtin_bit_cast(float, (lane & 16) ? r[0] : r[1]); }

#define WT_RSRC(ptr) __builtin_amdgcn_make_buffer_rsrc((void*)(ptr), 0, 0x7fffffff, 0x00020000)
#ifndef WT_AUX
#define WT_AUX 16
#endif
__device__ __forceinline__ void st16_wt(__amdgpu_buffer_rsrc_t r, size_t byte_off, v4u v) { __builtin_amdgcn_raw_buffer_store_b128(v, r, (unsigned)byte_off, 0, WT_AUX); }

namespace pg8 {
typedef unsigned short bf16_t;
constexpr int BM = 256, BK = 64, HALF = 128, HTB = HALF * BK * 2, STAGE_BYTES = 8 * HTB, NXCD = 8, WGM = 8;

__host__ __device__ __forceinline__ int lds_byte(int r, int c) { const int st = (r >> 4) * 2 + (c >> 5), rr = r & 15, cc = c & 31, ob = rr * 64 + cc * 2; return st * 1024 + (ob ^ (((ob >> 9) & 1) << 5)); }
__host__ __device__ __forceinline__ void stage_rc(int b, int& R, int& C) { const int st = b / 1024, sb = b % 1024, swz = sb ^ (((sb >> 9) & 1) << 5); R = (st >> 1) * 16 + swz / 64; C = (st & 1) * 32 + (swz % 64) / 2; }
__host__ __device__ __forceinline__ int perm32(int rho) { const int n = rho >> 4, i = rho & 15; return 8 * (i >> 2) + 4 * n + (i & 3); }

struct Unit { int pm, pn; };
struct Gemm { const bf16_t* A; const bf16_t* Bt; int M, N, K, lda, ldb; size_t a_pn_step; };

struct StaticOrder {
    int nM, nN, nwg, G, c;
    __host__ __device__ void init(int M, int N, int G_, int c_) { nM = M / BM; nN = N / BM; nwg = nM * nN; G = G_; c = c_; }
    __host__ __device__ bool next(int i, Unit& u) const {
        const long L = (long)i * G + c; if (L >= nwg) return false;
        int wgid = (int)L; { const int q = nwg / NXCD, r = nwg % NXCD, xcd = wgid % NXCD, off = wgid / NXCD; wgid = (xcd < r ? xcd * (q + 1) : r * (q + 1) + (xcd - r) * q) + off; }
        const int nig = WGM * nN, gid = wgid / nig, fm = gid * WGM, gsz = (nM - fm) < WGM ? (nM - fm) : WGM;
        u.pm = fm + ((wgid % nig) % gsz); u.pn = (wgid % nig) / gsz; return true;
    }
};

struct EpiBf16 {
    static constexpr bool PERM = true, AFTER_DRAIN = false;
    bf16_t* O; int ldc; const float* rope; int rope_lo, rope_hi;
    bf16_t* qkv;
    const float* rs;
    int silu_a, silu_b;
    __device__ __forceinline__ void operator()(f32x4 (&acc)[2][2][4][2], const Unit& u, int wr, int wc, int fr, int fq) const {
        const int row0 = u.pm * BM + wr * 64 + fr; const int col0 = u.pn * BM + wc * 32 + 8 * fq;
        if (rs) {
#pragma unroll
            for (int ai = 0; ai < 2; ++ai)
#pragma unroll
                for (int m = 0; m < 4; ++m) { const float r = rs[row0 + ai * HALF + m * 16];
#pragma unroll
                    for (int bj = 0; bj < 2; ++bj)
#pragma unroll
                        for (int n = 0; n < 2; ++n) acc[ai][bj][m][n] *= r; }
        }
        if (wc == 0 && u.pn >= rope_lo && u.pn < rope_hi) {
            const float sg = fq < 2 ? -1.f : 1.f;
#pragma unroll
            for (int ai = 0; ai < 2; ++ai)
#pragma unroll
                for (int m = 0; m < 4; ++m) {
                    const int pos = (row0 + ai * HALF + m * 16) & 2047;
                    const float* rp = rope + pos * 32 + 8 * (fq & 1);
                    const f32x4 c0 = *(const f32x4*)(rp), c1 = *(const f32x4*)(rp + 4), s0 = *(const f32x4*)(rp + 16) * sg, s1 = *(const f32x4*)(rp + 20) * sg;
#pragma unroll
                    for (int bj = 0; bj < 2; ++bj) {
                        f32x4 v0 = acc[ai][bj][m][0], v1 = acc[ai][bj][m][1], o0, o1;
#pragma unroll
                        for (int e = 0; e < 4; ++e) { o0[e] = lane_xor32(v0[e], fq << 4); o1[e] = lane_xor32(v1[e], fq << 4); }
                        acc[ai][bj][m][0] = v0 * c0 + o0 * s0; acc[ai][bj][m][1] = v1 * c1 + o1 * s1;
                    }
                }
        }
        const bool gate = (unsigned)(u.pn - silu_a) < 4u || (unsigned)(u.pn - silu_b) < 4u;
        const bool relay = qkv && u.pn >= 8 && u.pn < 44;
        const int hh0 = relay ? 2 * ((u.pn - 8) % 12) : 0, sh = 2 * (hh0 >> 3);
        const size_t tbase = relay ? ((size_t)((u.pn - 8) / 12) * 24 + hh0) * (size_t)(8192 * 128) : 0;
        const int ccol = qkv ? (u.pn < 8 ? u.pn * BM : 2048 + (u.pn - 44) * BM) + wc * 32 + 8 * fq : col0;
        const __amdgpu_buffer_rsrc_t rsrc = WT_RSRC(relay ? qkv : O);
#pragma unroll
        for (int ai = 0; ai < 2; ++ai)
#pragma unroll
            for (int m = 0; m < 4; ++m) { const int row = row0 + ai * HALF + m * 16;
                size_t roff;
                if (relay) { const int p = row & 2047, r = p & ((1 << sh) - 1), l = p >> sh; roff = tbase + (size_t)((row & ~2047) + r * (2048 >> sh) + l) * 128 + wc * 32 + 8 * fq; }
                else roff = (size_t)row * ldc + ccol;
                const size_t bjstep = relay ? (size_t)(8192 * 128) : (size_t)HALF;
#pragma unroll
                for (int bj = 0; bj < 2; ++bj) { f32x4 v0 = acc[ai][bj][m][0], v1 = acc[ai][bj][m][1];
                    if (gate) {
#pragma unroll
                        for (int e = 0; e < 4; ++e) { v0[e] = silu_f(v0[e]); v1[e] = silu_f(v1[e]); } }
                    v4u w; w.x = cvt_pk_bf16(v0[0], v0[1]); w.y = cvt_pk_bf16(v0[2], v0[3]); w.z = cvt_pk_bf16(v1[0], v1[1]); w.w = cvt_pk_bf16(v1[2], v1[3]);
                    st16_wt(rsrc, (roff + bj * bjstep) * 2, w); }
                asm volatile("" ::: "memory"); }
    }
};
struct EpiOdd {
    static constexpr bool PERM = true, AFTER_DRAIN = false;
    bf16_t* O; int ldc; float* vpart; const float* ss2; const float* rs;
    __device__ __forceinline__ void operator()(f32x4 (&acc)[2][2][4][2], const Unit& u, int wr, int wc, int fr, int fq) const {
        const int row0 = u.pm * BM + wr * 64 + fr; const int cw = wc * 32 + 8 * fq;
        const __amdgpu_buffer_rsrc_t rsrc = WT_RSRC(O);
#pragma unroll
        for (int ai = 0; ai < 2; ++ai)
#pragma unroll
            for (int m = 0; m < 4; ++m) { const int row = row0 + ai * HALF + m * 16; float r;
                if (ss2) { const f32x4 a = *(const f32x4*)(ss2 + (size_t)row * 8), b = *(const f32x4*)(ss2 + (size_t)row * 8 + 4); r = 1.f / sqrtf((((a[0] + a[1]) + (a[2] + a[3])) + ((b[0] + b[1]) + (b[2] + b[3]))) * (1.f / 2048.f) + 1e-6f); }
                else r = rs[row];
#pragma unroll
                for (int bj = 0; bj < 2; ++bj)
#pragma unroll
                    for (int n = 0; n < 2; ++n) acc[ai][bj][m][n] *= r; }
        const bool pair = u.pn < 8 || (u.pn >= 12 && u.pn < 20);
        if (pair) {
            const bool glu = u.pn >= 12; const int col0 = (glu ? 2048 + 128 * (u.pn - 12) : 128 * u.pn) + cw;
#pragma unroll
            for (int ai = 0; ai < 2; ++ai)
#pragma unroll
                for (int m = 0; m < 4; ++m) {
                    f32x4 o[2];
#pragma unroll
                    for (int n = 0; n < 2; ++n)
#pragma unroll
                        for (int e = 0; e < 4; ++e) { const float a = acc[ai][0][m][n][e], g = acc[ai][1][m][n][e]; const float sg = sigmoid_f(g); o[n][e] = glu ? a * sg : a * g * sg; }
                    v4u w; w.x = cvt_pk_bf16(o[0][0], o[0][1]); w.y = cvt_pk_bf16(o[0][2], o[0][3]); w.z = cvt_pk_bf16(o[1][0], o[1][1]); w.w = cvt_pk_bf16(o[1][2], o[1][3]);
                    st16_wt(rsrc, ((size_t)(row0 + ai * HALF + m * 16) * ldc + col0) * 2, w);
                    asm volatile("" ::: "memory");
                }
        } else {
            if (u.pn < 12) {
#pragma unroll
                for (int ai = 0; ai < 2; ++ai)
#pragma unroll
                    for (int m = 0; m < 4; ++m) {
                        float s1 = 0.f, s2 = 0.f;
#pragma unroll
                        for (int bj = 0; bj < 2; ++bj)
#pragma unroll
                            for (int n = 0; n < 2; ++n)
#pragma unroll
                                for (int e = 0; e < 4; ++e) { const float v = acc[ai][bj][m][n][e]; s1 += v; s2 += v * v; }
                        s1 += lane_xor16(s1, fq << 4); s2 += lane_xor16(s2, fq << 4); s1 += lane_xor32(s1, fq << 4); s2 += lane_xor32(s2, fq << 4);
                        if (fq == 0) *(f32x2*)(vpart + ((size_t)(row0 + ai * HALF + m * 16) * 16 + (u.pn - 8) * 4 + wc) * 2) = (f32x2){s1, s2};
                    }
            }
            const bool gate = u.pn >= 20; const int col0 = (gate ? 3072 + 256 * (u.pn - 20) : 1024 + 256 * (u.pn - 8)) + cw;
#pragma unroll
            for (int ai = 0; ai < 2; ++ai)
#pragma unroll
                for (int m = 0; m < 4; ++m) { const size_t roff = (size_t)(row0 + ai * HALF + m * 16) * ldc + col0;
#pragma unroll
                    for (int bj = 0; bj < 2; ++bj) { f32x4 v0 = acc[ai][bj][m][0], v1 = acc[ai][bj][m][1];
                        if (gate) {
#pragma unroll
                            for (int e = 0; e < 4; ++e) { v0[e] = silu_f(v0[e]); v1[e] = silu_f(v1[e]); } }
                        v4u w; w.x = cvt_pk_bf16(v0[0], v0[1]); w.y = cvt_pk_bf16(v0[2], v0[3]); w.z = cvt_pk_bf16(v1[0], v1[1]); w.w = cvt_pk_bf16(v1[2], v1[3]);
                        st16_wt(rsrc, (roff + bj * HALF) * 2, w); }
                    asm volatile("" ::: "memory"); }
        }
    }
};
struct EpiF32 {
    static constexpr bool PERM = false;
    float* O; int ldc;
    __device__ __forceinline__ void operator()(const f32x4 (&acc)[2][2][4][2], const Unit& u, int wr, int wc, int fr, int fq) const {
        const int row0 = u.pm * BM + wr * 64 + fr; const int col0 = u.pn * BM + wc * 32 + 4 * fq;
#pragma unroll
        for (int ai = 0; ai < 2; ++ai)
#pragma unroll
            for (int m = 0; m < 4; ++m) { float* rowp = O + (size_t)(row0 + ai * HALF + m * 16) * ldc + col0;
#pragma unroll
                for (int bj = 0; bj < 2; ++bj)
#pragma unroll
                    for (int n = 0; n < 2; ++n) *(f32x4*)(rowp + bj * HALF + n * 16) = acc[ai][bj][m][n]; }
    }
};
struct EpiPool {
    static constexpr bool PERM = true, AFTER_DRAIN = false;
    bf16_t* O; int ldc; const bf16_t* gate; int ldg; const float* scale;
    __device__ __forceinline__ void operator()(const f32x4 (&acc)[2][2][4][2], const Unit& u, int wr, int wc, int fr, int fq) const {
        const int row0 = u.pm * BM + wr * 64 + fr; const int col0 = u.pn * BM + wc * 32 + 8 * fq;
        const __amdgpu_buffer_rsrc_t rsrc = WT_RSRC(O);
#pragma unroll
        for (int bj = 0; bj < 2; ++bj) {
            const f32x4 s0 = *(const f32x4*)(scale + col0 + bj * HALF), s1 = *(const f32x4*)(scale + col0 + bj * HALF + 4);
#pragma unroll
            for (int ai = 0; ai < 2; ++ai)
#pragma unroll
                for (int m = 0; m < 4; ++m) { const size_t row = (size_t)(row0 + ai * HALF + m * 16);
                    const v4u gv = *(const v4u*)(gate + row * ldg + col0 + bj * HALF);
                    const f32x4 v0 = acc[ai][bj][m][0], v1 = acc[ai][bj][m][1];
                    v4u w;
                    w.x = cvt_pk_bf16(v0[0] * s0[0] * bflo(gv.x), v0[1] * s0[1] * bfhi(gv.x));
                    w.y = cvt_pk_bf16(v0[2] * s0[2] * bflo(gv.y), v0[3] * s0[3] * bfhi(gv.y));
                    w.z = cvt_pk_bf16(v1[0] * s1[0] * bflo(gv.z), v1[1] * s1[1] * bfhi(gv.z));
                    w.w = cvt_pk_bf16(v1[2] * s1[2] * bflo(gv.w), v1[3] * s1[3] * bfhi(gv.w));
                    st16_wt(rsrc, (row * ldc + col0 + bj * HALF) * 2, w);
                    if (m & 1) asm volatile("" ::: "memory"); }
        }
    }
};

template <class Epi, bool ALIGN_EPI>
__device__ __forceinline__ void gemm_phase(LAS unsigned char* lds, const Gemm g, const StaticOrder& S, const Epi& E) {
    const int tid = threadIdx.x, wid = __builtin_amdgcn_readfirstlane(tid >> 6), lane = tid & 63, wr = wid >> 2, wc = wid & 3, fr = lane & 15, fq = lane >> 4;
    const int K = g.K, nt = K / BK;
    unsigned voffA[2], voffB[2];
#pragma unroll
    for (int i = 0; i < 2; ++i) { int R, C; stage_rc(tid * 16 + i * 8192, R, C); const int Rb = Epi::PERM ? ((R & ~31) + perm32(R & 31)) : R;
        voffA[i] = (unsigned)(R * g.lda + C) * 2u; voffB[i] = (unsigned)(Rb * g.ldb + C) * 2u; }
    const size_t kstep = (size_t)(BK * 2);
    const size_t hstepA = (size_t)HALF * g.lda * 2, hstepB = (size_t)HALF * g.ldb * 2;
    const size_t tstepA = 2 * hstepA, tstepB = 2 * hstepB;
    const unsigned ldsw = (unsigned)wid * 1024u;
    const int aoff = lds_byte(wr * 64 + fr, fq * 8), boff = lds_byte(wc * 32 + fr, fq * 8);
#define PG8_SA(b, h) (((b) * 2 + (h)) * HTB)
#define PG8_SB(b, h) ((4 + (b) * 2 + (h)) * HTB)
#define PG8_STAGE(bufoff, gbase, voff) do { const char* gb_ = (const char*)(gbase); asm volatile("" : "+s"(gb_));   \
        _Pragma("unroll") for (int _i = 0; _i < 2; ++_i) \
        __builtin_amdgcn_global_load_lds((const unsigned*)(gb_ + (voff)[_i]), (LAS unsigned*)(lds + (bufoff) + ldsw + _i * 8192), 16, 0, 0); } while (0)
#define PG8_LDA(dst, b, h) do { _Pragma("unroll") for (int m = 0; m < 4; ++m) _Pragma("unroll") for (int k = 0; k < 2; ++k) dst[m][k] = *(const LAS bf16x8*)(lds + PG8_SA(b, h) + aoff + m * 2048 + k * 1024); } while (0)
#define PG8_LDB(dst, b, h) do { _Pragma("unroll") for (int n = 0; n < 2; ++n) _Pragma("unroll") for (int k = 0; k < 2; ++k) dst[n][k] = *(const LAS bf16x8*)(lds + PG8_SB(b, h) + boff + n * 2048 + k * 1024); } while (0)
#define PG8_MMA(ai, bj, At, Bt) do { __builtin_amdgcn_s_setprio(1); _Pragma("unroll") for (int m = 0; m < 4; ++m) _Pragma("unroll") for (int n = 0; n < 2; ++n) _Pragma("unroll") for (int k = 0; k < 2; ++k) \
        acc[ai][bj][m][n] = __builtin_amdgcn_mfma_f32_16x16x32_bf16(Bt[n][k], At[m][k], acc[ai][bj][m][n], 0, 0, 0); __builtin_amdgcn_s_setprio(0); } while (0)
#define PG8_WAIT_V(n) asm volatile("s_waitcnt vmcnt(" #n ")" ::: "memory")
#define PG8_WAIT_L(n) asm volatile("s_waitcnt lgkmcnt(" #n ")" ::: "memory")
#define PG8_BAR __builtin_amdgcn_s_barrier()
#define PG8_SCHED __builtin_amdgcn_sched_barrier(0)
    Unit cur, nxt; int ui = 0;
    if (!S.next(0, cur)) return;
    f32x4 acc[2][2][4][2];
#pragma unroll
    for (int a = 0; a < 2; ++a)
#pragma unroll
        for (int b = 0; b < 2; ++b)
#pragma unroll
            for (int m = 0; m < 4; ++m)
#pragma unroll
                for (int n = 0; n < 2; ++n) acc[a][b][m][n] = (f32x4){0.f, 0.f, 0.f, 0.f};
    bf16x8 At[4][2], B0[2][2], B1[2][2];
    const char* cA = (const char*)g.A + (size_t)cur.pm * tstepA + (size_t)cur.pn * g.a_pn_step; const char* cB = (const char*)g.Bt + (size_t)cur.pn * tstepB;
    PG8_STAGE(PG8_SB(0, 0), cB, voffB); PG8_STAGE(PG8_SB(0, 1), cB + hstepB, voffB); PG8_STAGE(PG8_SA(0, 0), cA, voffA); PG8_STAGE(PG8_SA(0, 1), cA + hstepA, voffA);
    if (wr == 1) PG8_BAR;
    PG8_WAIT_V(2); PG8_BAR;
    PG8_STAGE(PG8_SB(1, 0), cB + kstep, voffB); PG8_STAGE(PG8_SA(1, 0), cA + kstep, voffA); PG8_STAGE(PG8_SB(1, 1), cB + hstepB + kstep, voffB);
    PG8_WAIT_V(6); PG8_BAR;
    for (;;) {
        const bool has_next = S.next(ui + 1, nxt);
        const char* nA = has_next ? (const char*)g.A + (size_t)nxt.pm * tstepA + (size_t)nxt.pn * g.a_pn_step : cA; const char* nB = has_next ? (const char*)g.Bt + (size_t)nxt.pn * tstepB : cB;
        for (int t = 0; t < nt; t += 2) {
            const bool last = (t == nt - 2);
            const char* a1 = cA + (size_t)(t + 1) * kstep;
            const char* a2 = last ? nA : cA + (size_t)(t + 2) * kstep; const char* b2 = last ? nB : cB + (size_t)(t + 2) * kstep;
            const char* a3 = a2 + kstep; const char* b3 = b2 + kstep;
            PG8_LDB(B0, 0, 0); PG8_LDB(B1, 0, 1); PG8_SCHED; PG8_LDA(At, 0, 0); PG8_STAGE(PG8_SA(1, 1), a1 + hstepA, voffA);
            PG8_WAIT_V(8); PG8_WAIT_L(0); PG8_BAR; PG8_MMA(0, 0, At, B0); PG8_MMA(0, 1, At, B1); PG8_BAR; PG8_SCHED;
            PG8_LDA(At, 0, 1); PG8_STAGE(PG8_SB(0, 0), b2, voffB); PG8_STAGE(PG8_SB(0, 1), b2 + hstepB, voffB); PG8_STAGE(PG8_SA(0, 0), a2, voffA);
            PG8_WAIT_V(8); PG8_WAIT_L(0); PG8_BAR; PG8_MMA(1, 0, At, B0); PG8_MMA(1, 1, At, B1); PG8_BAR; PG8_SCHED;
            PG8_LDB(B0, 1, 0); PG8_LDB(B1, 1, 1); PG8_SCHED; PG8_LDA(At, 1, 0); PG8_STAGE(PG8_SA(0, 1), a2 + hstepA, voffA);
            PG8_WAIT_V(8); PG8_WAIT_L(0); PG8_BAR; PG8_MMA(0, 0, At, B0); PG8_MMA(0, 1, At, B1); PG8_BAR; PG8_SCHED;
            PG8_LDA(At, 1, 1); PG8_STAGE(PG8_SB(1, 0), b3, voffB); PG8_STAGE(PG8_SB(1, 1), b3 + hstepB, voffB); PG8_STAGE(PG8_SA(1, 0), a3, voffA);
            PG8_WAIT_V(8); PG8_WAIT_L(0); PG8_BAR; PG8_MMA(1, 0, At, B0); PG8_MMA(1, 1, At, B1); PG8_BAR; PG8_SCHED;
        }
        if constexpr (ALIGN_EPI) { if (wr == 0) PG8_BAR; }
        if constexpr (!Epi::AFTER_DRAIN) E(acc, cur, wr, wc, fr, fq);
        if (!has_next) break;
#pragma unroll
        for (int a = 0; a < 2; ++a)
#pragma unroll
            for (int b = 0; b < 2; ++b)
#pragma unroll
                for (int m = 0; m < 4; ++m)
#pragma unroll
                    for (int n = 0; n < 2; ++n) acc[a][b][m][n] = (f32x4){0.f, 0.f, 0.f, 0.f};
        cur = nxt; cA = nA; cB = nB; ++ui;
        if constexpr (ALIGN_EPI) { if (wr == 1) PG8_BAR; }
    }
    PG8_WAIT_V(0);
    if constexpr (!ALIGN_EPI) { if (wr == 0) PG8_BAR; }
    PG8_BAR;
    if constexpr (Epi::AFTER_DRAIN) E.fused(acc, cur, wr, wc, fr, fq, lds, tid, lane);
#undef PG8_SA
#undef PG8_SB
#undef PG8_STAGE
#undef PG8_LDA
#undef PG8_LDB
#undef PG8_MMA
#undef PG8_WAIT_V
#undef PG8_WAIT_L
#undef PG8_BAR
#undef PG8_SCHED
}
}

constexpr int NWAVES = 8, NTHREADS = 512;
constexpr int DM = 2048, SEQ = 2048, NB = 4, MTOK = NB * SEQ;
constexpr int EIN = 12288, OIN = 6144;
constexpr int ZGP = 3072, ZG_AIN = 0, ZG_AGATE = 1024, ZG_BGATE = 2048;
constexpr int ZC_AIN = 0, ZC_AGATE = 1024, ZC_Q = 2048, ZC_K = 5120, ZC_V = 8192, ZC_BGATE = 11264;
constexpr int O2 = 4096, OC_UG = 0, OC_V = 1024, OC_DD = 2048, OC_DG = 3072;
constexpr float EPS = 1e-6f;

constexpr size_t MiB = 1u << 20;
constexpr size_t WS_W1 = 1 * MiB;
constexpr size_t WS_OG = WS_W1;
constexpr size_t WS_W2 = 49 * MiB;
constexpr size_t WS_W3 = 57 * MiB;
constexpr size_t WS_W4 = 81 * MiB;
constexpr size_t WS_PW = 89 * MiB;
constexpr size_t WS_SGW = WS_PW + 512 * 1024;
constexpr size_t WS_ROPE = WS_SGW + 128 * 1024;
constexpr size_t WS_LSE = 90 * MiB;
constexpr size_t WS_XN = 91 * MiB;
constexpr size_t WS_MIX = WS_XN;
constexpr size_t WS_Z = 123 * MiB;
constexpr size_t WS_Y = WS_Z;
constexpr size_t WS_ZG = WS_Z, WS_Q = WS_Z + 48 * MiB, WS_K = WS_Z + 96 * MiB, WS_V = WS_Z + 144 * MiB;
constexpr size_t WS_Z1 = WS_Z + 64 * MiB;
constexpr size_t WS_X1B = WS_Z + 32 * MiB;
constexpr size_t WS_R1 = WS_LSE + 800 * 1024;
constexpr size_t WS_POOLED = 315 * MiB;
constexpr size_t WS_VPART = WS_POOLED;
constexpr size_t WS_XB = 331 * MiB;
constexpr size_t WS_R0 = WS_R1 + 32 * 1024;
constexpr size_t WS_SS = WS_POOLED + 2 * MiB;
constexpr size_t WS_SS2 = WS_POOLED + 3 * MiB;
constexpr size_t WS_END = 363 * MiB;

constexpr int LDS_BYTES = 147456;


#define XB_TMO      128
#define XB_XCNT(j)  (256  + 64 * (j))
#define XB_XSUB(j)  (1280 + 64 * (j))
#define XB_XGEN(j)  (2304 + 64 * (j))
#define XB_TOP      3328
#define XB_TOPGEN   3392
#define XCD_BAR_WORDS 3456
#define XB_SPIN_CAP (1u << 18)
__device__ __forceinline__ unsigned xb_ld(unsigned* p)              { return __hip_atomic_load(p, __ATOMIC_RELAXED, __HIP_MEMORY_SCOPE_AGENT); }
__device__ __forceinline__ unsigned xb_add(unsigned* p, unsigned v) { return __hip_atomic_fetch_add(p, v, __ATOMIC_RELAXED, __HIP_MEMORY_SCOPE_AGENT); }
__device__ __forceinline__ unsigned xb_xcc_id() { return (unsigned)__builtin_amdgcn_s_getreg((3 << 11) | 20) & 0xFu; }
#define XB_SPIN(cond, bar) do { unsigned _sp = 0; while (cond) { __builtin_amdgcn_s_sleep(1); \
    if ((++_sp & 255u) == 0u) { if (xb_ld(&(bar)[XB_TMO])) break; if (_sp > XB_SPIN_CAP) { atomicAdd(&(bar)[XB_TMO], 1u); break; } } } } while (0)
struct XcdBarrier { unsigned* bar; unsigned x; volatile LAS unsigned* st; };
__device__ __forceinline__ XcdBarrier xcd_barrier_post(unsigned* bar, volatile LAS unsigned* st) {
    XcdBarrier b; b.bar = bar; b.x = xb_xcc_id(); b.st = st;
    if (threadIdx.x == 0) (void)xb_add(&bar[XB_XCNT(b.x)], 1u);
    return b;
}
__device__ __forceinline__ void xcd_barrier_complete(unsigned* bar, unsigned x, unsigned& nloc, unsigned& nx) {
    const unsigned G = gridDim.x * gridDim.y * gridDim.z;
    unsigned sum, cnt, mine, sp = 0u;
    for (;;) {
        sum = 0u; cnt = 0u; mine = 0u;
#pragma unroll
        for (unsigned j = 0; j < 16; ++j) { const unsigned c = xb_ld(&bar[XB_XCNT(j)]); sum += c; cnt += (c > 0u) ? 1u : 0u; mine = (j == x) ? c : mine; }
        if (sum == G) break;
        __builtin_amdgcn_s_sleep(1);
        if ((++sp & 255u) == 0u) { if (xb_ld(&bar[XB_TMO])) break; if (sp > XB_SPIN_CAP) { atomicAdd(&bar[XB_TMO], 1u); break; } }
    }
    nloc = mine > 0u ? mine : 1u; nx = cnt > 0u ? cnt : 1u;
}
__device__ __forceinline__ void xcd_barrier(const XcdBarrier& b) {
    asm volatile("s_waitcnt vmcnt(0)" ::: "memory");
    __syncthreads();
    if (threadIdx.x == 0) {
        unsigned* bar = b.bar;
        __builtin_amdgcn_s_waitcnt(0);
        unsigned nloc = b.st[0], nx = b.st[1];
        if (nloc == 0u) { xcd_barrier_complete(bar, b.x, nloc, nx); b.st[0] = nloc; b.st[1] = nx; }
        const unsigned old = xb_add(&bar[XB_XSUB(b.x)], 1u);
        const unsigned gen = old / nloc;
        if (old + 1u == (gen + 1u) * nloc) {
            __builtin_amdgcn_fence(__ATOMIC_RELEASE, "agent");
            asm volatile("s_waitcnt vmcnt(0)" ::: "memory");
            const unsigned og = xb_add(&bar[XB_TOP], 1u);
            const unsigned tg = og / nx;
            if (og + 1u == (tg + 1u) * nx) xb_add(&bar[XB_TOPGEN], 1u);
            else XB_SPIN(xb_ld(&bar[XB_TOPGEN]) == tg, bar);
            __builtin_amdgcn_fence(__ATOMIC_ACQUIRE, "agent");
            xb_add(&bar[XB_XGEN(b.x)], 1u);
            asm volatile("s_waitcnt vmcnt(0)" ::: "memory");
        } else {
            XB_SPIN(xb_ld(&bar[XB_XGEN(b.x)]) == gen, bar);
            __builtin_amdgcn_fence(__ATOMIC_ACQUIRE, "agent");
            asm volatile("s_waitcnt vmcnt(0)" ::: "memory");
        }
    }
    __syncthreads();
}

struct EpiFinal {
    static constexpr bool PERM = true, AFTER_DRAIN = true;
    const bf16* X1; float* out; const float* gpost; float* ss; XcdBarrier bar;
    __device__ __forceinline__ void fused(f32x4 (&acc)[2][2][4][2], const pg8::Unit& u, int wr, int wc, int fr, int fq, LAS unsigned char* lds, int tid, int lane) const {
        LAS float* P = (LAS float*)lds;
#pragma unroll
        for (int ai = 0; ai < 2; ++ai)
#pragma unroll
            for (int m = 0; m < 4; ++m) {
                float sq = 0.f;
#pragma unroll
                for (int bj = 0; bj < 2; ++bj)
#pragma unroll
                    for (int n = 0; n < 2; ++n) { const f32x4 v = acc[ai][bj][m][n]; sq += (v[0] * v[0] + v[1] * v[1]) + (v[2] * v[2] + v[3] * v[3]); }
                sq += lane_xor16(sq, fq << 4); sq += lane_xor32(sq, fq << 4);
                if (fq == 0) P[(ai * 128 + wr * 64 + m * 16 + fr) * 4 + wc] = sq;
            }
        __syncthreads();
        if (tid < 256) { const f32x4 p = *(const LAS f32x4*)(P + tid * 4); ss[((size_t)u.pm * 256 + tid) * 8 + u.pn] = (p[0] + p[1]) + (p[2] + p[3]); }
        xcd_barrier(bar);
        const int row0 = u.pm * 256 + wr * 64 + fr;
#pragma unroll
        for (int ai = 0; ai < 2; ++ai)
#pragma unroll
            for (int m = 0; m < 4; ++m) {
                const size_t row = (size_t)(row0 + ai * 128 + m * 16);
                const f32x4 a = *(const f32x4*)(ss + row * 8), b = *(const f32x4*)(ss + row * 8 + 4);
                const float r = 1.f / sqrtf((((a[0] + a[1]) + (a[2] + a[3])) + ((b[0] + b[1]) + (b[2] + b[3]))) * (1.f / DM) + EPS);
#pragma unroll
                for (int bj = 0; bj < 2; ++bj) {
                    const int col0 = u.pn * 256 + bj * 128 + wc * 32 + 8 * fq;
                    const v4u xb = *(const v4u*)(X1 + row * DM + col0);
                    const f32x4 g0 = *(const f32x4*)(gpost + col0), g1 = *(const f32x4*)(gpost + col0 + 4);
                    const f32x4 o0 = (f32x4){bflo(xb.x), bfhi(xb.x), bflo(xb.y), bfhi(xb.y)} + acc[ai][bj][m][0] * r * g0;
                    const f32x4 o1 = (f32x4){bflo(xb.z), bfhi(xb.z), bflo(xb.w), bfhi(xb.w)} + acc[ai][bj][m][1] * r * g1;
                    *(f32x4*)(out + row * DM + col0) = o0; *(f32x4*)(out + row * DM + col0 + 4) = o1;
                }
                asm volatile("" ::: "memory");
            }
    }
};

struct EpiMid {
    static constexpr bool PERM = true, AFTER_DRAIN = true;
    const bf16* XB; bf16* X1; const float* gpost; float* ss; float* ss2; XcdBarrier bar;
    __device__ __forceinline__ void fused(f32x4 (&acc)[2][2][4][2], const pg8::Unit& u, int wr, int wc, int fr, int fq, LAS unsigned char* lds, int tid, int lane) const {
        LAS float* P = (LAS float*)lds;
#pragma unroll
        for (int ai = 0; ai < 2; ++ai)
#pragma unroll
            for (int m = 0; m < 4; ++m) {
                float sq = 0.f;
#pragma unroll
                for (int bj = 0; bj < 2; ++bj)
#pragma unroll
                    for (int n = 0; n < 2; ++n) { const f32x4 v = acc[ai][bj][m][n]; sq += (v[0] * v[0] + v[1] * v[1]) + (v[2] * v[2] + v[3] * v[3]); }
                sq += lane_xor16(sq, fq << 4); sq += lane_xor32(sq, fq << 4);
                if (fq == 0) P[(ai * 128 + wr * 64 + m * 16 + fr) * 4 + wc] = sq;
            }
        __syncthreads();
        if (tid < 256) { const f32x4 p = *(const LAS f32x4*)(P + tid * 4); ss[((size_t)u.pm * 256 + tid) * 8 + u.pn] = (p[0] + p[1]) + (p[2] + p[3]); }
        xcd_barrier(bar);
        const int row0 = u.pm * 256 + wr * 64 + fr;
#pragma unroll
        for (int ai = 0; ai < 2; ++ai)
#pragma unroll
            for (int m = 0; m < 4; ++m) {
                const size_t row = (size_t)(row0 + ai * 128 + m * 16);
                const f32x4 a = *(const f32x4*)(ss + row * 8), b = *(const f32x4*)(ss + row * 8 + 4);
                const float r = 1.f / sqrtf((((a[0] + a[1]) + (a[2] + a[3])) + ((b[0] + b[1]) + (b[2] + b[3]))) * (1.f / DM) + EPS);
                float sq = 0.f;
#pragma unroll
                for (int bj = 0; bj < 2; ++bj) {
                    const int col0 = u.pn * 256 + bj * 128 + wc * 32 + 8 * fq;
                    const v4u xb = *(const v4u*)(XB + row * DM + col0);
                    const f32x4 g0 = *(const f32x4*)(gpost + col0), g1 = *(const f32x4*)(gpost + col0 + 4);
                    const f32x4 o0 = (f32x4){bflo(xb.x), bfhi(xb.x), bflo(xb.y), bfhi(xb.y)} + acc[ai][bj][m][0] * r * g0;
                    const f32x4 o1 = (f32x4){bflo(xb.z), bfhi(xb.z), bflo(xb.w), bfhi(xb.w)} + acc[ai][bj][m][1] * r * g1;
                    sq += ((o0[0] * o0[0] + o0[1] * o0[1]) + (o0[2] * o0[2] + o0[3] * o0[3])) + ((o1[0] * o1[0] + o1[1] * o1[1]) + (o1[2] * o1[2] + o1[3] * o1[3]));
                    v4u w; w.x = cvt_pk_bf16(o0[0], o0[1]); w.y = cvt_pk_bf16(o0[2], o0[3]); w.z = cvt_pk_bf16(o1[0], o1[1]); w.w = cvt_pk_bf16(o1[2], o1[3]);
                    *(v4u*)(X1 + row * DM + col0) = w;
                }
                sq += lane_xor16(sq, fq << 4); sq += lane_xor32(sq, fq << 4);
                if (fq == 0) P[(ai * 128 + wr * 64 + m * 16 + fr) * 4 + wc] = sq;
                asm volatile("" ::: "memory");
            }
        __syncthreads();
        if (tid < 256) { const f32x4 p = *(const LAS f32x4*)(P + tid * 4); ss2[((size_t)u.pm * 256 + tid) * 8 + u.pn] = (p[0] + p[1]) + (p[2] + p[3]); }
    }
};

struct TrItem { const float* src; bf16* dst; int N, K; const float* gk; };
__device__ __forceinline__ void p0_tr_load(const TrItem& t, float (&v)[32], int lane) {
#pragma unroll
    for (int i = 0; i < 32; ++i) v[i] = __builtin_nontemporal_load(t.src + (size_t)(2 * i + (lane >> 5)) * t.N + (lane & 31));
}
__device__ __forceinline__ void p0_tr_store(const TrItem& t, const float (&v)[32], LAS float* scr, int lane) {
#pragma unroll
    for (int i = 0; i < 32; ++i) scr[(2 * i + (lane >> 5)) * 33 + (lane & 31)] = v[i];
    asm volatile("s_waitcnt lgkmcnt(0)" ::: "memory");
    const int c = lane & 7;
    f32x4 g0 = (f32x4){1.f, 1.f, 1.f, 1.f}, g1 = g0;
    if (t.gk) { g0 = *(const f32x4*)(t.gk + 8 * c); g1 = *(const f32x4*)(t.gk + 8 * c + 4); }
#pragma unroll
    for (int j = 0; j < 4; ++j) { const int n = (lane >> 3) + 8 * j; const LAS float* sp = scr + (8 * c) * 33 + n;
        v4u o; o.x = cvt_pk_bf16(sp[0 * 33] * g0[0], sp[1 * 33] * g0[1]); o.y = cvt_pk_bf16(sp[2 * 33] * g0[2], sp[3 * 33] * g0[3]); o.z = cvt_pk_bf16(sp[4 * 33] * g1[0], sp[5 * 33] * g1[1]); o.w = cvt_pk_bf16(sp[6 * 33] * g1[2], sp[7 * 33] * g1[3]);
        *(v4u*)(t.dst + (size_t)n * t.K + 8 * c) = o; }
    asm volatile("s_waitcnt lgkmcnt(0)" ::: "memory");
}
__device__ __forceinline__ void rows2_to_bf16_rms(const float* x0, const float* x1, bf16* o0, bf16* o1, float* r0, float* r1, int lane) {
    const f32x4* xa = (const f32x4*)x0 + lane; const f32x4* xb = (const f32x4*)x1 + lane;
    f32x4 va[8], vb[8]; float sa = 0.f, sb = 0.f;
#pragma unroll
    for (int j = 0; j < 8; ++j) { va[j] = __builtin_nontemporal_load(xa + 64 * j); vb[j] = __builtin_nontemporal_load(xb + 64 * j); }
#pragma unroll
    for (int j = 0; j < 8; ++j) { sa += (va[j].x * va[j].x + va[j].y * va[j].y) + (va[j].z * va[j].z + va[j].w * va[j].w); sb += (vb[j].x * vb[j].x + vb[j].y * vb[j].y) + (vb[j].z * vb[j].z + vb[j].w * vb[j].w); }
    sa = wave_sum(sa); sb = wave_sum(sb);
    if (lane == 0) { *r0 = 1.f / sqrtf(sa * (1.f / DM) + EPS); *r1 = 1.f / sqrtf(sb * (1.f / DM) + EPS); }
    v2u* pa = (v2u*)o0 + lane; v2u* pb = (v2u*)o1 + lane;
#pragma unroll
    for (int j = 0; j < 8; ++j) {
        v2u w; w.x = cvt_pk_bf16(va[j].x, va[j].y); w.y = cvt_pk_bf16(va[j].z, va[j].w); pa[64 * j] = w;
        v2u u; u.x = cvt_pk_bf16(vb[j].x, vb[j].y); u.y = cvt_pk_bf16(vb[j].z, vb[j].w); pb[64 * j] = u; }
}

typedef short s16x4 __attribute__((ext_vector_type(4)));
constexpr int KP = 136;
constexpr int VP = 144;
static_assert(2 * 128 * KP * 2 + 2 * 128 * VP * 2 <= LDS_BYTES - 16, "attention LDS");

constexpr int KT_BYTES = 128 * KP * 2, VT_BYTES = 128 * VP * 2;
struct AttStep { int d, r, qt, hh, b, L; int g, h; };
__device__ __forceinline__ AttStep att_decode(int step) {
    AttStep a; const int g = step >> 9, w = step & 511;
    const int nl = 4 - 2 * g, dl = 2 * g;
    const int qt = w & ((1 << nl) - 1), seq = w >> nl, r = seq & ((1 << dl) - 1), bh = seq >> dl;
    const int b = bh >> 3, h = bh & 7;
    a.d = 1 << dl; a.r = r; a.qt = qt; a.g = g; a.h = h; a.hh = g * 8 + h; a.b = b; a.L = SEQ >> dl; return a;
}
__device__ __forceinline__ void att_load_tile(const bf16* Z, const AttStep& a, int tile, int tid, v4u (&kv)[4], v4u (&vv)[4]) {
    const int kl = tid >> 4, ch = tid & 15;
    const bf16* base = Z + ((size_t)a.hh * 8192 + (a.b << 11) + a.r * a.L + 128 * tile + kl) * 128 + 8 * ch;
#pragma unroll
    for (int ps = 0; ps < 4; ++ps) { kv[ps] = *(const v4u*)(base + (size_t)(WS_K - WS_Q) / 2 + ps * 32 * 128); vv[ps] = *(const v4u*)(base + (size_t)(WS_V - WS_Q) / 2 + ps * 32 * 128); }
}
__device__ __forceinline__ void att_store_tile(LAS unsigned char* kbuf, LAS unsigned char* vbuf, int tid, const v4u (&kv)[4], const v4u (&vv)[4]) {
    const int kl = tid >> 4, ch = tid & 15;
#pragma unroll
    for (int ps = 0; ps < 4; ++ps) { const int kk = ps * 32 + kl; *(LAS v4u*)((LAS bf16*)kbuf + kk * KP + 8 * ch) = kv[ps]; *(LAS v4u*)((LAS bf16*)vbuf + kk * VP + 8 * ch) = vv[ps]; }
}
__device__ __forceinline__ void att_load_q(const bf16* Z, const AttStep& a, int wave, int lane, bf16x8 (&qf)[4]) {
    const bf16* qp = Z + ((size_t)a.hh * 8192 + (a.b << 11) + a.r * a.L + 128 * a.qt + 16 * wave + (lane & 15)) * 128 + 8 * (lane >> 4);
#pragma unroll
    for (int ks = 0; ks < 4; ++ks) qf[ks] = *(const bf16x8*)(qp + 32 * ks);
}
__device__ __forceinline__ void attn_phase(LAS unsigned char* lds, const bf16* Z, bf16* OG, float* LSE, int s0, int s1, int tid, int lane, int wave) {
    if (s0 >= s1) return;
    const int quad = lane >> 4;
    int par = 0;
    int s0v = s0; asm volatile("" : "+v"(s0v));
    AttStep cur = att_decode(s0v);
    int cur_qt = __builtin_amdgcn_readfirstlane(cur.qt);
    bf16x8 qf[4];
    {
        v4u kv[4], vv[4], kp[4], vp[4];
        att_load_tile(Z, cur, cur.qt, tid, kv, vv);
        if (cur_qt > 0) att_load_tile(Z, cur, cur.qt - 1, tid, kp, vp);
        att_load_q(Z, cur, wave, lane, qf);
        att_store_tile(lds, lds + 2 * KT_BYTES, tid, kv, vv);
        if (cur_qt > 0) att_store_tile(lds + KT_BYTES, lds + 2 * KT_BYTES + VT_BYTES, tid, kp, vp);
    }
    for (int step = s0; step < s1; ++step) {
        const bool has_next = step + 1 < s1;
        AttStep nxt = cur; v4u nkv[4], nvv[4]; bf16x8 nqf[4];
        if (has_next) { int sv = step + 1; asm volatile("" : "+v"(sv)); nxt = att_decode(sv); att_load_tile(Z, nxt, nxt.qt, tid, nkv, nvv); att_load_q(Z, nxt, wave, lane, nqf); }
        __syncthreads();
        const bool has_prev = cur_qt > 0;
        const int qq = 16 * wave + (lane & 15);
        const int np = has_prev ? 8 - wave : 0;
        int kaddr[9], vaddr[9], krel[9];
#pragma unroll
        for (int i = 0; i < 9; ++i) {
            const bool isp = i < np; const int c = i - np; const bool dummy = !isp && c >= 8;
            const int kt = isp ? wave + i : (dummy ? 0 : c);
            const int slot = isp ? (par ^ 1) : par;
            kaddr[i] = slot * KT_BYTES + kt * (16 * KP * 2); vaddr[i] = 2 * KT_BYTES + slot * VT_BYTES + kt * (16 * VP * 2);
            krel[i] = dummy ? 100000 : (isp ? 16 * kt - 128 : 16 * kt);
        }
        const LAS unsigned char* klane = lds + ((lane & 15) * KP + 8 * quad) * 2;
        f32x4 s[9];
#pragma unroll
        for (int i = 0; i < 9; ++i) {
            s[i] = (f32x4){0.f, 0.f, 0.f, 0.f};
#pragma unroll
            for (int ks = 0; ks < 4; ++ks) s[i] = __builtin_amdgcn_mfma_f32_16x16x32_bf16(*(const LAS bf16x8*)(klane + kaddr[i] + 64 * ks), qf[ks], s[i], 0, 0, 0);
        }
        const float sc = 0.08838834764831845f * 1.4426950408889634f;
        float mx = -INFINITY;
#pragma unroll
        for (int i = 0; i < 9; ++i)
#pragma unroll
            for (int j = 0; j < 4; ++j) { const int rel = krel[i] + 4 * quad + j; const bool valid = (rel <= qq) && (rel >= qq - 128); const float t = valid ? s[i][j] * sc : -INFINITY; s[i][j] = t; mx = fmaxf(mx, t); }
        mx = fmaxf(mx, lane_xor16(mx, lane)); mx = fmaxf(mx, lane_xor32(mx, lane));
        float l = 0.f;
#pragma unroll
        for (int i = 0; i < 9; ++i)
#pragma unroll
            for (int j = 0; j < 4; ++j) { const float p = __builtin_amdgcn_exp2f(s[i][j] - mx); s[i][j] = p; l += p; }
        l += lane_xor16(l, lane); l += lane_xor32(l, lane);
        f32x4 o[8];
#pragma unroll
        for (int dt = 0; dt < 8; ++dt) o[dt] = (f32x4){0.f, 0.f, 0.f, 0.f};
        {
            const int tq = (lane & 15) >> 2, tp = lane & 3; const LAS unsigned char* vlane = lds + ((4 * quad + tq) * VP + 4 * tp) * 2;
#pragma unroll
            for (int m = 0; m < 5; ++m) {
                const int ia = 2 * m, ib = (m < 4) ? 2 * m + 1 : 8;
                v4u w; w.x = cvt_pk_bf16(s[ia][0], s[ia][1]); w.y = cvt_pk_bf16(s[ia][2], s[ia][3]);
                if (m < 4) { w.z = cvt_pk_bf16(s[ib][0], s[ib][1]); w.w = cvt_pk_bf16(s[ib][2], s[ib][3]); } else { w.z = 0u; w.w = 0u; }
                const bf16x8 pf = __builtin_bit_cast(bf16x8, w);
#pragma unroll
                for (int dt = 0; dt < 8; ++dt) {
                    const s16x4 lo = __builtin_amdgcn_ds_read_tr16_b64_v4i16((LAS s16x4*)(vlane + vaddr[ia] + 32 * dt));
                    const s16x4 hi = __builtin_amdgcn_ds_read_tr16_b64_v4i16((LAS s16x4*)(vlane + vaddr[ib] + 32 * dt));
                    bf16x8 av; av[0] = lo[0]; av[1] = lo[1]; av[2] = lo[2]; av[3] = lo[3]; av[4] = hi[0]; av[5] = hi[1]; av[6] = hi[2]; av[7] = hi[3];
                    o[dt] = __builtin_amdgcn_mfma_f32_16x16x32_bf16(av, pf, o[dt], 0, 0, 0);
                }
            }
        }
        {
            const int pq = (128 * cur.qt + qq) * cur.d + cur.r;
            const float inv = 1.f / l; const size_t row = (size_t)(cur.b << 11) + pq;
            bf16* op = OG + ((size_t)cur.g * MTOK + row) * 1024 + cur.h * 128 + 4 * quad;
#pragma unroll
            for (int dt = 0; dt < 8; ++dt) { v2u w; w.x = cvt_pk_bf16(o[dt][0] * inv, o[dt][1] * inv); w.y = cvt_pk_bf16(o[dt][2] * inv, o[dt][3] * inv); *(v2u*)(op + 16 * dt) = w; }
            if (quad == 0) LSE[((size_t)cur.g * MTOK + row) * 8 + cur.h] = (mx + __log2f(l)) * 0.6931471805599453f;
        }
        __syncthreads();
        if (has_next) {
            att_store_tile(lds + (par ^ 1) * KT_BYTES, lds + 2 * KT_BYTES + (par ^ 1) * VT_BYTES, tid, nkv, nvv);
#pragma unroll
            for (int ks = 0; ks < 4; ++ks) qf[ks] = nqf[ks];
            cur = nxt; cur_qt = __builtin_amdgcn_readfirstlane(cur.qt); par ^= 1;
        }
    }
    __syncthreads();
}

template <int W>
__device__ __forceinline__ void pool_run(const bf16* zc, bf16* pc, int t0) {
    v4u v[W + 7];
#pragma unroll
    for (int k = 0; k < W + 7; ++k) { const int dr = k - (W - 1); v[k] = (t0 + dr >= 0) ? *(const v4u*)(zc + (ptrdiff_t)dr * ZGP) : (v4u){0u, 0u, 0u, 0u}; }
    float S[8];
#pragma unroll
    for (int e = 0; e < 8; ++e) S[e] = 0.f;
#pragma unroll
    for (int k = 0; k < W - 1; ++k) { S[0] += bflo(v[k].x); S[1] += bfhi(v[k].x); S[2] += bflo(v[k].y); S[3] += bfhi(v[k].y); S[4] += bflo(v[k].z); S[5] += bfhi(v[k].z); S[6] += bflo(v[k].w); S[7] += bfhi(v[k].w); }
#pragma unroll
    for (int i = 0; i < 8; ++i) {
        const v4u c = v[W - 1 + i];
        const float a0 = bflo(c.x), a1 = bfhi(c.x), a2 = bflo(c.y), a3 = bfhi(c.y), a4 = bflo(c.z), a5 = bfhi(c.z), a6 = bflo(c.w), a7 = bfhi(c.w);
        S[0] += a0; S[1] += a1; S[2] += a2; S[3] += a3; S[4] += a4; S[5] += a5; S[6] += a6; S[7] += a7;
        const int cnt = (t0 + i + 1 < W) ? (t0 + i + 1) : W; const float ic = 1.f / (float)cnt;
        v4u o; o.x = cvt_pk_bf16(S[0] * ic - a0, S[1] * ic - a1); o.y = cvt_pk_bf16(S[2] * ic - a2, S[3] * ic - a3); o.z = cvt_pk_bf16(S[4] * ic - a4, S[5] * ic - a5); o.w = cvt_pk_bf16(S[6] * ic - a6, S[7] * ic - a7);
        *(v4u*)(pc + (size_t)i * 1024) = o;
        const v4u d = v[i];
        S[0] -= bflo(d.x); S[1] -= bfhi(d.x); S[2] -= bflo(d.y); S[3] -= bfhi(d.y); S[4] -= bflo(d.z); S[5] -= bfhi(d.z); S[6] -= bflo(d.w); S[7] -= bfhi(d.w);
    }
}

constexpr int SP = 272;
constexpr int SGU_STAT_OFF = 128 * SP * 2;
__device__ __forceinline__ void sgu_unit(LAS unsigned char* lds, const bf16* Z1, const float* VPART, const bf16* SGW, const float* ng, const float* nb, const float* sbias, bf16* MIX, int unit, int tid, int lane, int wave) {
    const int chunk = unit >> 2, h = unit & 3;
    const size_t row0 = (size_t)chunk * 128;
    LAS bf16* Vn = (LAS bf16*)lds; LAS float* st = (LAS float*)(lds + SGU_STAT_OFF);
    if (tid < 128) {
        const f32x4* pp = (const f32x4*)(VPART + (row0 + tid) * 32);
        float s1 = 0.f, s2 = 0.f;
#pragma unroll
        for (int q = 0; q < 8; ++q) { const f32x4 a = pp[q]; s1 += a.x + a.z; s2 += a.y + a.w; }
        const float mu = s1 * (1.f / 1024.f); const float var = fmaxf(s2 * (1.f / 1024.f) - mu * mu, 0.f);
        st[tid] = mu; st[128 + tid] = 1.f / sqrtf(var + EPS);
    }
    __syncthreads();
    {
        const int tl = tid >> 5, ch = tid & 31;
        const f32x4 g0 = *(const f32x4*)(ng + h * 256 + 8 * ch), g1 = *(const f32x4*)(ng + h * 256 + 8 * ch + 4), b0 = *(const f32x4*)(nb + h * 256 + 8 * ch), b1 = *(const f32x4*)(nb + h * 256 + 8 * ch + 4);
        v4u a[8];
#pragma unroll
        for (int ps = 0; ps < 8; ++ps) a[ps] = *(const v4u*)(Z1 + (row0 + 16 * ps + tl) * O2 + OC_V + h * 256 + 8 * ch);
#pragma unroll
        for (int ps = 0; ps < 8; ++ps) {
            const int j = 16 * ps + tl; const float mu = st[j], rs = st[128 + j];
            v4u w;
            w.x = cvt_pk_bf16((bflo(a[ps].x) - mu) * rs * g0[0] + b0[0], (bfhi(a[ps].x) - mu) * rs * g0[1] + b0[1]);
            w.y = cvt_pk_bf16((bflo(a[ps].y) - mu) * rs * g0[2] + b0[2], (bfhi(a[ps].y) - mu) * rs * g0[3] + b0[3]);
            w.z = cvt_pk_bf16((bflo(a[ps].z) - mu) * rs * g1[0] + b1[0], (bfhi(a[ps].z) - mu) * rs * g1[1] + b1[1]);
            w.w = cvt_pk_bf16((bflo(a[ps].w) - mu) * rs * g1[2] + b1[2], (bfhi(a[ps].w) - mu) * rs * g1[3] + b1[3]);
            *(LAS v4u*)(Vn + j * SP + 8 * ch) = w;
        }
    }
    const int fr = lane & 15, quad = lane >> 4;
    const int ti = 16 * wave + fr;
    bf16x8 wf[4];
    {
        const bf16* wp = SGW + ((size_t)h * 128 + ti) * 128 + 4 * quad;
#pragma unroll
        for (int ks = 0; ks < 4; ++ks) { const v2u lo = *(const v2u*)(wp + 32 * ks), hi = *(const v2u*)(wp + 32 * ks + 16); v4u w; w.x = lo.x; w.y = lo.y; w.z = hi.x; w.w = hi.y; wf[ks] = __builtin_bit_cast(bf16x8, w); }
    }
    __syncthreads();
    v2u uu[16];
    {
        const bf16* up = Z1 + (row0 + ti) * O2 + OC_UG + h * 256 + 4 * quad;
#pragma unroll
        for (int ct = 0; ct < 16; ++ct) uu[ct] = *(const v2u*)(up + 16 * ct);
    }
    f32x4 acc[16];
#pragma unroll
    for (int ct = 0; ct < 16; ++ct) acc[ct] = (f32x4){0.f, 0.f, 0.f, 0.f};
    const int nks = (wave >> 1) + 1;
    {
        const int tq = fr >> 2, tp = lane & 3;
        const LAS bf16* vbase = Vn + (4 * quad + tq) * SP + 4 * tp;
#pragma unroll
        for (int ks = 0; ks < 4; ++ks) {
            if (ks < nks) {
#pragma unroll
                for (int ct = 0; ct < 16; ++ct) {
                    const LAS bf16* vp = vbase + (32 * ks) * SP + 16 * ct;
                    const s16x4 lo = __builtin_amdgcn_ds_read_tr16_b64_v4i16((LAS s16x4*)vp);
                    const s16x4 hi = __builtin_amdgcn_ds_read_tr16_b64_v4i16((LAS s16x4*)(vp + 16 * SP));
                    bf16x8 av; av[0] = lo[0]; av[1] = lo[1]; av[2] = lo[2]; av[3] = lo[3]; av[4] = hi[0]; av[5] = hi[1]; av[6] = hi[2]; av[7] = hi[3];
                    acc[ct] = __builtin_amdgcn_mfma_f32_16x16x32_bf16(av, wf[ks], acc[ct], 0, 0, 0);
                }
            }
        }
    }
    {
        const float bias = sbias[h * 128 + ti];
        const size_t row = row0 + ti;
        bf16* op = MIX + row * DM + h * 256 + 4 * quad;
#pragma unroll
        for (int ct = 0; ct < 16; ++ct) {
            const v2u u = uu[ct];
            v2u w;
            w.x = cvt_pk_bf16(bflo(u.x) * (acc[ct][0] + bias), bfhi(u.x) * (acc[ct][1] + bias));
            w.y = cvt_pk_bf16(bflo(u.y) * (acc[ct][2] + bias), bfhi(u.y) * (acc[ct][3] + bias));
            *(v2u*)(op + 16 * ct) = w;
        }
    }
    __syncthreads();
}

constexpr int CONV_T = 32, CONV_ROWS = CONV_T + 30;
constexpr int CONV_RED_OFF = CONV_ROWS * 1024 * 2;
static_assert(CONV_RED_OFF + 32 * 8 * 4 + 32 * 4 <= LDS_BYTES, "conv LDS");
__device__ __forceinline__ void conv_unit(LAS unsigned char* lds, const bf16* Z1, const float* cw, const float* cb, const float* lg, const float* lb, bf16* MIX, int unit, int tid, int lane, int wave) {
    const size_t row0 = (size_t)unit * CONV_T;
    const int pos0 = (int)(row0 % SEQ);
    LAS unsigned* Dt = (LAS unsigned*)lds;
    LAS float* red = (LAS float*)(lds + CONV_RED_OFF); LAS float* stat = red + 32 * 8;
#pragma unroll 1
    for (int i0 = 0; i0 < 16; i0 += 8) {
        v4u a[8];
#pragma unroll
        for (int i = 0; i < 8; ++i) {
            const int idx = tid + (i0 + i) * NTHREADS; const int rr = idx >> 7, cbk = idx & 127;
            a[i] = (v4u){0u, 0u, 0u, 0u};
            if (rr < CONV_ROWS && pos0 + rr - 30 >= 0) a[i] = *(const v4u*)(Z1 + (row0 + rr - 30) * O2 + OC_DD + 8 * cbk);
        }
#pragma unroll
        for (int i = 0; i < 8; ++i) { const int idx = tid + (i0 + i) * NTHREADS; const int rr = idx >> 7, cbk = idx & 127; if (rr < CONV_ROWS) *(LAS v4u*)(Dt + rr * 512 + 4 * cbk) = a[i]; }
    }
    asm volatile("" ::: "memory");
    f32x2 wk[31];
#pragma unroll
    for (int k = 0; k < 31; ++k) wk[k] = *(const f32x2*)(cw + k * 1024 + 2 * tid);
    const f32x2 bias = *(const f32x2*)(cb + 2 * tid);
    __syncthreads();
    const f32x2 gg = *(const f32x2*)(lg + 2 * tid), bb = *(const f32x2*)(lb + 2 * tid);
#pragma unroll 1
    for (int hb = 0; hb < CONV_T; hb += 16) {
        f32x2 y[16];
#pragma unroll
        for (int t = 0; t < 16; ++t) {
            f32x2 a2 = bias;
#pragma unroll
            for (int k = 0; k < 31; ++k) { const unsigned v = Dt[(hb + t + k) * 512 + tid]; f32x2 in; in.x = bflo(v); in.y = bfhi(v); a2 = __builtin_elementwise_fma(wk[k], in, a2); }
            y[t] = a2;
        }
#pragma unroll
        for (int t = 0; t < 16; ++t) { const float sm = wave_sum(y[t].x + y[t].y); if (lane == 0) red[t * 8 + wave] = sm; }
        __syncthreads();
        if (tid < 16) { float sm = 0.f;
#pragma unroll
            for (int w = 0; w < 8; ++w) sm += red[tid * 8 + w];
            stat[tid] = sm * (1.f / 1024.f); }
        __syncthreads();
#pragma unroll
        for (int t = 0; t < 16; ++t) { const float mu = stat[t]; y[t].x -= mu; y[t].y -= mu; }
#pragma unroll
        for (int t = 0; t < 16; ++t) { const float sq = wave_sum(y[t].x * y[t].x + y[t].y * y[t].y); if (lane == 0) red[t * 8 + wave] = sq; }
        __syncthreads();
        if (tid < 16) { float sq = 0.f;
#pragma unroll
            for (int w = 0; w < 8; ++w) sq += red[tid * 8 + w];
            stat[16 + tid] = 1.f / sqrtf(sq * (1.f / 1024.f) + EPS); }
        __syncthreads();
        unsigned gtl[16];
#pragma unroll
        for (int t = 0; t < 16; ++t) gtl[t] = *(const unsigned*)(Z1 + (row0 + hb + t) * O2 + OC_DG + 2 * tid);
#pragma unroll
        for (int t = 0; t < 16; ++t) {
            const float rs = stat[16 + t];
            const unsigned gtv = gtl[t];
            const float v0 = silu_f(y[t].x * rs * gg.x + bb.x) * bflo(gtv), v1 = silu_f(y[t].y * rs * gg.y + bb.y) * bfhi(gtv);
            *(unsigned*)(MIX + (row0 + hb + t) * DM + 1024 + 2 * tid) = cvt_pk_bf16(v0, v1);
        }
        __syncthreads();
    }
}

struct Args { const float* in[19]; float* out; unsigned char* ws; int ph_lo, ph_hi; };

__global__ void __launch_bounds__(NTHREADS, 2) mega_fwd(Args args) {
    extern __shared__ __attribute__((aligned(16))) unsigned char lds_raw[];
    LAS unsigned char* lds = (LAS unsigned char*)lds_raw;
    {
        if (threadIdx.x < 4) ((LAS unsigned*)(lds + LDS_BYTES - 16))[threadIdx.x] = 0u;
        __syncthreads();
    }
    const XcdBarrier gbar = xcd_barrier_post((unsigned*)args.ws, (volatile LAS unsigned*)(lds + LDS_BYTES - 16));
    const int G = gridDim.x, bid = blockIdx.x;
    const int NGW = G * NWAVES, NGT = G * NTHREADS;
#define FRESH_IDS() int tid = threadIdx.x; asm volatile("" : "+v"(tid)); const int lane = tid & 63, wave = __builtin_amdgcn_readfirstlane(tid >> 6); \
    const int gw = bid * NWAVES + wave, gt = bid * NTHREADS + tid; (void)lane; (void)gw; (void)gt;
#define WSP(T, off) ((T*)(args.ws + (off)))
#define INP(k) (args.in[k])
    const int lo = args.ph_lo, hi = args.ph_hi;
#define IN(k) (lo <= (k) && (k) < hi)
#define SEAM(k) do { if (IN(k) && IN((k) + 1)) { xcd_barrier(gbar); for (int xs_ = 0; xs_ < XSYNC; ++xs_) xcd_barrier(gbar); } } while (0)

    if (IN(0)) for (int rep_ = 0; rep_ < REP0; ++rep_) {
        FRESH_IDS();
        const float* x = INP(0); const float* e_pre = INP(1); const float* e_w_in = INP(2); const float* e_pool_w = INP(3); const float* e_w_out = INP(5);
        const float* o_w_in = INP(8); const float* o_sgu_w = INP(11); const float* o_w_out = INP(17); const float* o_pre = INP(7);
        bf16* W1 = WSP(bf16, WS_W1); bf16* W2 = WSP(bf16, WS_W2); bf16* W3 = WSP(bf16, WS_W3); bf16* W4 = WSP(bf16, WS_W4);
        bf16* PW = WSP(bf16, WS_PW); bf16* SGW = WSP(bf16, WS_SGW); float* ROPE = WSP(float, WS_ROPE);
        LAS float* scr = (LAS float*)(lds + wave * 17408);
        constexpr int I1 = (DM / 64) * (EIN / 32), I2 = (DM / 64) * (DM / 32), I3 = (DM / 64) * (OIN / 32), I4 = I2, IPG = (256 / 64) * (256 / 32), IP = 4 * IPG;
        constexpr int NIT = I1 + I2 + I3 + I4 + IP;
        auto mk = [&](int it) -> TrItem {
            const float* W; bf16* WT; int K, N, r = it, ro = 0; bool perm3 = false;
            if (r < I1) { W = e_w_in; WT = W1; K = DM; N = EIN; }
            else if ((r -= I1) < I2) { W = e_w_out; WT = W2; K = DM; N = DM; }
            else if ((r -= I2) < I3) { W = o_w_in; WT = W3; K = DM; N = OIN; perm3 = true; }
            else if ((r -= I3) < I4) { W = o_w_out; WT = W4; K = DM; N = DM; }
            else { r -= I4; const int pg = r / IPG; r -= pg * IPG; W = e_pool_w + (size_t)pg * 65536; WT = PW; K = 256; N = 256; ro = pg * 256; }
            const int nblk = N / 32, kb = r / nblk, nb = r % nblk;
            int drow = ro + 32 * nb;
            if (perm3) {
                const int c = 32 * nb, seg = c >> 10, cc = c & 1023, tt = cc >> 7, j = cc & 127;
                drow = seg == 0 ? 256 * tt + j : seg == 1 ? 2048 + cc : seg == 2 ? 256 * tt + 128 + j : seg == 3 ? 3072 + 256 * tt + j : seg == 4 ? 3072 + 256 * tt + 128 + j : 5120 + cc;
            }
            TrItem t; t.src = W + (size_t)(64 * kb) * N + 32 * nb; t.dst = WT + (size_t)drow * K + 64 * kb; t.N = N; t.K = K; t.gk = perm3 ? o_pre + 64 * kb : (WT == W1 ? e_pre + 64 * kb : nullptr); return t;
        };
        for (int it = gw; it < NIT; it += 2 * NGW) {
            const bool two = (it + NGW) < NIT;
            const TrItem t0 = mk(it), t1 = mk(two ? it + NGW : it);
            float v0[32], v1[32];
            p0_tr_load(t0, v0, lane); p0_tr_load(t1, v1, lane);
            p0_tr_store(t0, v0, scr, lane);
            if (two) p0_tr_store(t1, v1, scr + 64 * 33, lane);
        }
        { bf16* XB = WSP(bf16, WS_XB); float* R0 = WSP(float, WS_R0);
          for (int m = 2 * gw; m < MTOK; m += 2 * NGW) rows2_to_bf16_rms(x + (size_t)m * DM, x + (size_t)(m + 1) * DM, XB + (size_t)m * DM, XB + (size_t)(m + 1) * DM, R0 + m, R0 + m + 1, lane); }
        for (int i = gt; i < 4 * 128 * 128; i += NGT) { const int jj = i & 127, ii = (i >> 7) & 127; const float v = (jj <= ii) ? o_sgu_w[i] : 0.f; SGW[i] = (bf16)(cvt_pk_bf16(v, 0.f) & 0xffffu); }
        for (int i = gt; i < SEQ * 16; i += NGT) {
            const int p = i >> 4, f = i & 15;
            double rr = sqrt(sqrt(sqrt(sqrt(1.0 / 500000.0)))); double inv = 1.0;
            for (int e = 0; e < f; ++e) inv *= rr;
            const float ang = (float)p * (float)inv;
            const double xa = (double)ang; const double n = rint(xa * 0.15915494309189535); const float red = (float)(xa - n * 6.283185307179586);
            ROPE[p * 32 + f] = cosf(red); ROPE[p * 32 + 16 + f] = sinf(red);
        }
    }
    SEAM(0);
    if (IN(1)) for (int rep_ = 0; rep_ < REP1; ++rep_) {
        pg8::Gemm g{WSP(bf16, WS_XB), WSP(bf16, WS_W1), MTOK, EIN, DM, DM, DM, 0}; pg8::StaticOrder S; S.init(MTOK, EIN, G, bid);
        pg8::EpiBf16 E{WSP(bf16, WS_ZG), ZGP, WSP(float, WS_ROPE), 8, 32, WSP(bf16, WS_Q), WSP(float, WS_R0), 4, 44};
        pg8::gemm_phase<pg8::EpiBf16, true>(lds, g, S, E);
    }
    SEAM(1);
    if (IN(2)) for (int rep_ = 0; rep_ < REP2; ++rep_) {
        FRESH_IDS();
        const bf16* Z = WSP(bf16, WS_ZG); const bf16* QB = WSP(bf16, WS_Q); bf16* POOLED = WSP(bf16, WS_POOLED);
#ifndef NO_ATTN
        attn_phase(lds, QB, WSP(bf16, WS_OG), WSP(float, WS_LSE), (int)((long)bid * 1536 / G), (int)((long)(bid + 1) * 1536 / G), tid, lane, wave);
#endif
        for (int wv = gw; wv < 2048; wv += NGW) {
            const int grp = wv & 3, run = (wv >> 2) * 2 + (lane >> 5), c = grp * 256 + (lane & 31) * 8, row = run * 8;
            const bf16* zc = Z + (size_t)row * ZGP + ZG_AIN + c; bf16* pc = POOLED + (size_t)row * 1024 + c; const int t0 = row & (SEQ - 1);
            if (grp == 0) pool_run<2>(zc, pc, t0); else if (grp == 1) pool_run<4>(zc, pc, t0); else if (grp == 2) pool_run<8>(zc, pc, t0); else pool_run<16>(zc, pc, t0);
        }
    }
    SEAM(2);
    if (IN(3)) for (int rep_ = 0; rep_ < REP3; ++rep_) {
        {
            pg8::Gemm g{WSP(bf16, WS_POOLED), WSP(bf16, WS_PW), MTOK, 1024, 256, 1024, 256, 512}; pg8::StaticOrder S; S.init(MTOK, 1024, G, bid);
            pg8::EpiPool E{WSP(bf16, WS_MIX), DM, WSP(bf16, WS_ZG) + ZG_AGATE, ZGP, INP(4)};
            pg8::gemm_phase<pg8::EpiPool, true>(lds, g, S, E);
        }
        FRESH_IDS();
        const bf16* Z = WSP(bf16, WS_ZG); const bf16* OG = WSP(bf16, WS_OG); const float* LSE = WSP(float, WS_LSE); bf16* MIX = WSP(bf16, WS_MIX);
        const int mfirst = (G > 128) ? 128 : 0, mcus = G - mfirst;
        const int gtm = (bid - mfirst) * NTHREADS + tid, NGTM = mcus * NTHREADS;
        if (bid >= mfirst)
#pragma unroll 1
        for (int i0 = gtm; i0 < MTOK * 128; i0 += 4 * NGTM) {
            v4u a[4], b[4], d[4], gv[4]; float l0[4], l1[4], l2[4];
#pragma unroll
            for (int q = 0; q < 4; ++q) {
                int i = i0 + q * NGTM; if (i >= MTOK * 128) i = gtm;
                const int row = i >> 7, c = (i & 127) * 8, h = c >> 7;
                l0[q] = LSE[(size_t)row * 8 + h]; l1[q] = LSE[((size_t)MTOK + row) * 8 + h]; l2[q] = LSE[((size_t)2 * MTOK + row) * 8 + h];
                a[q] = *(const v4u*)(OG + (size_t)row * 1024 + c); b[q] = *(const v4u*)(OG + ((size_t)MTOK + row) * 1024 + c); d[q] = *(const v4u*)(OG + ((size_t)2 * MTOK + row) * 1024 + c);
                gv[q] = *(const v4u*)(Z + (size_t)row * ZGP + ZG_BGATE + c);
            }
#pragma unroll
            for (int q = 0; q < 4; ++q) {
                const int i = i0 + q * NGTM; if (i >= MTOK * 128) continue;
                const int row = i >> 7, c = (i & 127) * 8;
                const float m = fmaxf(l0[q], fmaxf(l1[q], l2[q]));
                float w0 = __expf(l0[q] - m), w1 = __expf(l1[q] - m), w2 = __expf(l2[q] - m); const float inv = 1.f / (w0 + w1 + w2); w0 *= inv; w1 *= inv; w2 *= inv;
                v4u o;
                o.x = cvt_pk_bf16((w0 * bflo(a[q].x) + w1 * bflo(b[q].x) + w2 * bflo(d[q].x)) * bflo(gv[q].x), (w0 * bfhi(a[q].x) + w1 * bfhi(b[q].x) + w2 * bfhi(d[q].x)) * bfhi(gv[q].x));
                o.y = cvt_pk_bf16((w0 * bflo(a[q].y) + w1 * bflo(b[q].y) + w2 * bflo(d[q].y)) * bflo(gv[q].y), (w0 * bfhi(a[q].y) + w1 * bfhi(b[q].y) + w2 * bfhi(d[q].y)) * bfhi(gv[q].y));
                o.z = cvt_pk_bf16((w0 * bflo(a[q].z) + w1 * bflo(b[q].z) + w2 * bflo(d[q].z)) * bflo(gv[q].z), (w0 * bfhi(a[q].z) + w1 * bfhi(b[q].z) + w2 * bfhi(d[q].z)) * bfhi(gv[q].z));
                o.w = cvt_pk_bf16((w0 * bflo(a[q].w) + w1 * bflo(b[q].w) + w2 * bflo(d[q].w)) * bflo(gv[q].w), (w0 * bfhi(a[q].w) + w1 * bfhi(b[q].w) + w2 * bfhi(d[q].w)) * bfhi(gv[q].w));
                *(v4u*)(MIX + (size_t)row * DM + 1024 + c) = o;
            }
        }
    }
    SEAM(3);
    if (IN(4)) for (int rep_ = 0; rep_ < REP4; ++rep_) {
        pg8::Gemm g{WSP(bf16, WS_MIX), WSP(bf16, WS_W2), MTOK, DM, DM, DM, DM, 0}; pg8::StaticOrder S; S.init(MTOK, DM, G, bid);
        if (G == 256) {
            EpiMid E{WSP(bf16, WS_XB), WSP(bf16, WS_X1B), INP(6), WSP(float, WS_SS), WSP(float, WS_SS2), gbar};
            pg8::gemm_phase<EpiMid, false>(lds, g, S, E);
        } else {
            pg8::EpiBf16 E{WSP(bf16, WS_Y), DM, nullptr, 0, 0, nullptr, nullptr, -8, -8};
            pg8::gemm_phase<pg8::EpiBf16, false>(lds, g, S, E);
        }
    }
    if (G != 256) SEAM(4);
    if (IN(5) && G != 256) for (int rep_ = 0; rep_ < REP5; ++rep_) {
        FRESH_IDS();
        const bf16* XB = WSP(bf16, WS_XB); const float* e_post = INP(6); const bf16* Y = WSP(bf16, WS_Y); bf16* X1B = WSP(bf16, WS_X1B); float* R1 = WSP(float, WS_R1);
        for (int m0 = 2 * gw; m0 < MTOK; m0 += 2 * NGW) {
            f32x4 v[2][8], xv[2][8];
#pragma unroll
            for (int q = 0; q < 2; ++q) {
                const v4u* yr = (const v4u*)(Y + (size_t)(m0 + q) * DM) + lane; const v4u* xr = (const v4u*)(XB + (size_t)(m0 + q) * DM) + lane;
#pragma unroll
                for (int j = 0; j < 4; ++j) { const v4u y = yr[64 * j]; v[q][2 * j] = (f32x4){bflo(y.x), bfhi(y.x), bflo(y.y), bfhi(y.y)}; v[q][2 * j + 1] = (f32x4){bflo(y.z), bfhi(y.z), bflo(y.w), bfhi(y.w)}; }
#pragma unroll
                for (int j = 0; j < 4; ++j) { const v4u y = xr[64 * j]; xv[q][2 * j] = (f32x4){bflo(y.x), bfhi(y.x), bflo(y.y), bfhi(y.y)}; xv[q][2 * j + 1] = (f32x4){bflo(y.z), bfhi(y.z), bflo(y.w), bfhi(y.w)}; }
            }
            float s[2] = {0.f, 0.f};
#pragma unroll
            for (int q = 0; q < 2; ++q)
#pragma unroll
                for (int j = 0; j < 8; ++j) s[q] += (v[q][j].x * v[q][j].x + v[q][j].y * v[q][j].y) + (v[q][j].z * v[q][j].z + v[q][j].w * v[q][j].w);
#pragma unroll
            for (int q = 0; q < 2; ++q) s[q] = wave_sum(s[q]);
            float s1[2] = {0.f, 0.f};
#pragma unroll
            for (int q = 0; q < 2; ++q) { const float r = 1.f / sqrtf(s[q] * (1.f / DM) + EPS);
#pragma unroll
                for (int j = 0; j < 8; ++j) { const f32x4 gg = ((const f32x4*)e_post)[128 * (j >> 1) + 2 * lane + (j & 1)]; v[q][j] = xv[q][j] + v[q][j] * r * gg; s1[q] += (v[q][j].x * v[q][j].x + v[q][j].y * v[q][j].y) + (v[q][j].z * v[q][j].z + v[q][j].w * v[q][j].w); } }
#pragma unroll
            for (int q = 0; q < 2; ++q) s1[q] = wave_sum(s1[q]);
#pragma unroll
            for (int q = 0; q < 2; ++q) {
                if (lane == 0) R1[m0 + q] = 1.f / sqrtf(s1[q] * (1.f / DM) + EPS);
                v4u* o8 = (v4u*)(X1B + (size_t)(m0 + q) * DM) + lane;
#pragma unroll
                for (int j = 0; j < 4; ++j) { const f32x4 a = v[q][2 * j], b = v[q][2 * j + 1];
                    v4u w; w.x = cvt_pk_bf16(a.x, a.y); w.y = cvt_pk_bf16(a.z, a.w); w.z = cvt_pk_bf16(b.x, b.y); w.w = cvt_pk_bf16(b.z, b.w); o8[64 * j] = w; } }
        }
    }
    SEAM(5);
    if (IN(6)) for (int rep_ = 0; rep_ < REP6; ++rep_) {
        pg8::Gemm g{WSP(bf16, WS_X1B), WSP(bf16, WS_W3), MTOK, OIN, DM, DM, DM, 0}; pg8::StaticOrder S; S.init(MTOK, OIN, G, bid);
        pg8::EpiOdd E{WSP(bf16, WS_Z1), O2, WSP(float, WS_VPART), (G == 256) ? WSP(float, WS_SS2) : (float*)nullptr, WSP(float, WS_R1)};
        pg8::gemm_phase<pg8::EpiOdd, true>(lds, g, S, E);
    }
    SEAM(6);
    if (IN(7)) for (int rep_ = 0; rep_ < REP7; ++rep_) {
        FRESH_IDS();
        const bf16* Z1 = WSP(bf16, WS_Z1); bf16* MIX = WSP(bf16, WS_MIX);
#ifndef NO_SGU
        for (int u = bid; u < 256; u += G) sgu_unit(lds, Z1, WSP(float, WS_VPART), WSP(bf16, WS_SGW), INP(9), INP(10), INP(12), MIX, u, tid, lane, wave);
#endif
        asm volatile("" ::: "memory");
#ifndef NO_CONV
        for (int u = bid; u < 256; u += G) conv_unit(lds, Z1, INP(13), INP(14), INP(15), INP(16), MIX, u, tid, lane, wave);
#endif
    }
    SEAM(7);
    if (IN(8)) for (int rep_ = 0; rep_ < REP8; ++rep_) {
        pg8::Gemm g{WSP(bf16, WS_MIX), WSP(bf16, WS_W4), MTOK, DM, DM, DM, DM, 0}; pg8::StaticOrder S; S.init(MTOK, DM, G, bid);
        if (G == 256) {
            EpiFinal E{WSP(bf16, WS_X1B), args.out, INP(18), WSP(float, WS_SS), gbar};
            pg8::gemm_phase<EpiFinal, false>(lds, g, S, E);
        } else {
            pg8::EpiBf16 E{WSP(bf16, WS_Y), DM, nullptr, 0, 0, nullptr, nullptr, -8, -8};
            pg8::gemm_phase<pg8::EpiBf16, false>(lds, g, S, E);
        }
    }
    if (G != 256) SEAM(8);
    if (IN(9) && G != 256) {
        FRESH_IDS();
        const float* o_post = INP(18); const bf16* Y = WSP(bf16, WS_Y); const bf16* X1B = WSP(bf16, WS_X1B); float* out = args.out;
        for (int m0 = 2 * gw; m0 < MTOK; m0 += 2 * NGW) {
            f32x4 v[2][8], xv[2][8];
#pragma unroll
            for (int q = 0; q < 2; ++q) {
                const v4u* yr = (const v4u*)(Y + (size_t)(m0 + q) * DM) + lane; const v4u* xr = (const v4u*)(X1B + (size_t)(m0 + q) * DM) + lane;
#pragma unroll
                for (int j = 0; j < 4; ++j) { const v4u y = yr[64 * j]; v[q][2 * j] = (f32x4){bflo(y.x), bfhi(y.x), bflo(y.y), bfhi(y.y)}; v[q][2 * j + 1] = (f32x4){bflo(y.z), bfhi(y.z), bflo(y.w), bfhi(y.w)}; }
#pragma unroll
                for (int j = 0; j < 4; ++j) { const v4u y = xr[64 * j]; xv[q][2 * j] = (f32x4){bflo(y.x), bfhi(y.x), bflo(y.y), bfhi(y.y)}; xv[q][2 * j + 1] = (f32x4){bflo(y.z), bfhi(y.z), bflo(y.w), bfhi(y.w)}; }
            }
            float s[2] = {0.f, 0.f};
#pragma unroll
            for (int q = 0; q < 2; ++q)
#pragma unroll
                for (int j = 0; j < 8; ++j) s[q] += (v[q][j].x * v[q][j].x + v[q][j].y * v[q][j].y) + (v[q][j].z * v[q][j].z + v[q][j].w * v[q][j].w);
#pragma unroll
            for (int q = 0; q < 2; ++q) s[q] = wave_sum(s[q]);
#pragma unroll
            for (int q = 0; q < 2; ++q) { const float r = 1.f / sqrtf(s[q] * (1.f / DM) + EPS); f32x4* orow = (f32x4*)(out + (size_t)(m0 + q) * DM) + 2 * lane;
#pragma unroll
                for (int j = 0; j < 8; ++j) { const f32x4 gg = ((const f32x4*)o_post)[128 * (j >> 1) + 2 * lane + (j & 1)]; orow[128 * (j >> 1) + (j & 1)] = xv[q][j] + v[q][j] * r * gg; } }
        }
    }
#ifdef EXTRA_PH
    if (IN(10)) { FRESH_IDS(); const bf16* Z = WSP(bf16, WS_Q); attn_phase(lds, Z, WSP(bf16, WS_OG), WSP(float, WS_LSE), (int)((long)bid * 1536 / G), (int)((long)(bid + 1) * 1536 / G), tid, lane, wave); }
    if (IN(12)) { FRESH_IDS(); for (int u = bid; u < 256; u += G) sgu_unit(lds, WSP(bf16, WS_Z1), WSP(float, WS_VPART), WSP(bf16, WS_SGW), INP(9), INP(10), INP(12), WSP(bf16, WS_MIX), u, tid, lane, wave); }
    if (IN(13)) { FRESH_IDS(); for (int u = bid; u < 256; u += G) conv_unit(lds, WSP(bf16, WS_Z1), INP(13), INP(14), INP(15), INP(16), WSP(bf16, WS_MIX), u, tid, lane, wave); }
#endif
#undef IN
#undef SEAM
}

extern "C" void kernel_launch(void* const* d_in, const int* in_sizes, int n_in, void* d_out, int out_size, void* d_ws, size_t ws_size, hipStream_t stream) {
    static int grid = 0;
    if (grid == 0) {
        if (n_in != 19 || out_size != MTOK * DM || ws_size < WS_END) { fprintf(stderr, "kernel_launch: unexpected shapes (n_in %d, out %d, ws %zu)\n", n_in, out_size, ws_size); grid = -1; return; }
        int dev = 0, cus = 0, per_cu = 0;
        if (hipGetDevice(&dev) != hipSuccess || hipDeviceGetAttribute(&cus, hipDeviceAttributeMultiprocessorCount, dev) != hipSuccess) { grid = -1; return; }
        if (hipFuncSetAttribute((const void*)mega_fwd, hipFuncAttributeMaxDynamicSharedMemorySize, LDS_BYTES) != hipSuccess) { fprintf(stderr, "kernel_launch: hipFuncSetAttribute failed\n"); grid = -1; return; }
        if (hipOccupancyMaxActiveBlocksPerMultiprocessor(&per_cu, (const void*)mega_fwd, NTHREADS, LDS_BYTES) != hipSuccess || per_cu < 1) { fprintf(stderr, "kernel_launch: occupancy query gave %d\n", per_cu); per_cu = 1; }
        (void)hipGetLastError();
        grid = cus * per_cu;
    }
    if (grid < 0) return;
    Args a{};
    for (int i = 0; i < 19; ++i) a.in[i] = (const float*)d_in[i];
    a.out = (float*)d_out; a.ws = (unsigned char*)d_ws;
#if MK_N_LAUNCHES == 1
    a.ph_lo = 0; a.ph_hi = 10;
    (void)hipMemsetAsync(d_ws, 0, 16384, stream);
    hipLaunchKernelGGL(mega_fwd, dim3(grid), dim3(NTHREADS), LDS_BYTES, stream, a);
#ifdef EXTRA_PH
    for (int i = 0; i < EXTRA_N; ++i) { Args b = a; b.ph_lo = EXTRA_PH; b.ph_hi = EXTRA_PH + 1; hipLaunchKernelGGL(mega_fwd, dim3(grid), dim3(NTHREADS), LDS_BYTES, stream, b); }
#endif
#else
    for (int p = 0; p < 10; ++p) { a.ph_lo = p; a.ph_hi = p + 1; hipLaunchKernelGGL(mega_fwd, dim3(grid), dim3(NTHREADS), LDS_BYTES, stream, a); }
#endif
}
```

```cpp
#include <hip/hip_runtime.h>
#include <cstdio>
#include <cstdint>

#ifndef MK_N_LAUNCHES
#define MK_N_LAUNCHES 1
#endif

#ifndef REP0
#define REP0 1
#endif
#ifndef REP1
#define REP1 1
#endif
#ifndef REP2
#define REP2 1
#endif
#ifndef REP3
#define REP3 1
#endif
#ifndef REP4
#define REP4 1
#endif
#ifndef REP5
#define REP5 1
#endif
#ifndef REP6
#define REP6 1
#endif
#ifndef REP7
#define REP7 1
#endif
#ifndef REP8
#define REP8 1
#endif
#ifndef XSYNC
#define XSYNC 0
#endif
#ifndef SGU_TPS
#define SGU_TPS 2
#endif
#define LAS __attribute__((address_space(3)))
typedef unsigned short bf16;
typedef short bf16x8 __attribute__((ext_vector_type(8)));
typedef float f32x4 __attribute__((ext_vector_type(4)));
typedef float f32x2 __attribute__((ext_vector_type(2)));
typedef unsigned v4u __attribute__((ext_vector_type(4)));
typedef unsigned v2u __attribute__((ext_vector_type(2)));

__device__ __forceinline__ unsigned cvt_pk_bf16(float lo, float hi) { unsigned r; asm volatile("v_cvt_pk_bf16_f32 %0, %1, %2" : "=v"(r) : "v"(lo), "v"(hi)); return r; }
__device__ __forceinline__ float bflo(unsigned u) { return __uint_as_float(u << 16); }
__device__ __forceinline__ float bfhi(unsigned u) { return __uint_as_float(u & 0xffff0000u); }
__device__ __forceinline__ float silu_f(float x) { return x / (1.f + __expf(-x)); }
__device__ __forceinline__ float sigmoid_f(float x) { return 1.f / (1.f + __expf(-x)); }
#define DPP_ADD(v, ctrl) ((v) + __builtin_bit_cast(float, __builtin_amdgcn_update_dpp(0, __builtin_bit_cast(int, (v)), (ctrl), 0xF, 0xF, true)))
__device__ __forceinline__ float row_sum16(float v) {
    v = DPP_ADD(v, 0xB1); v = DPP_ADD(v, 0x4E); v = DPP_ADD(v, 0x141); v = DPP_ADD(v, 0x140); return v;
}
__device__ __forceinline__ float rdlane(float v, int l) { return __builtin_bit_cast(float, __builtin_amdgcn_readlane(__builtin_bit_cast(int, v), l)); }
__device__ __forceinline__ float wave_sum(float v) { v = row_sum16(v); return (rdlane(v, 0) + rdlane(v, 16)) + (rdlane(v, 32) + rdlane(v, 48)); }
__device__ __forceinline__ float lane_xor32(float v, int lane) { const auto r = __builtin_amdgcn_permlane32_swap(__builtin_bit_cast(unsigned, v), __builtin_bit_cast(unsigned, v), false, false); return __builtin_bit_cast(float, (lane & 32) ? r[0] : r[1]); }
__device__ __forceinline__ float lane_xor16(float v, int lane) { const auto r = __builtin_amdgcn_permlane16_swap(__builtin_bit_cast(unsigned, v), __builtin_bit_cast(unsigned, v), false, false); return __builtin_bit_cast(float, (lane & 16) ? r[0] : r[1]); }

namespace pg8 {
typedef unsigned short bf16_t;
constexpr int BM = 256, BK = 64, HALF = 128, HTB = HALF * BK * 2, STAGE_BYTES = 8 * HTB, NXCD = 8, WGM = 8;

__host__ __device__ __forceinline__ int lds_byte(int r, int c) { const int st = (r >> 4) * 2 + (c >> 5), rr = r & 15, cc = c & 31, ob = rr * 64 + cc * 2; return st * 1024 + (ob ^ (((ob >> 9) & 1) << 5)); }
__host__ __device__ __forceinline__ void stage_rc(int b, int& R, int& C) { const int st = b / 1024, sb = b % 1024, swz = sb ^ (((sb >> 9) & 1) << 5); R = (st >> 1) * 16 + swz / 64; C = (st & 1) * 32 + (swz % 64) / 2; }
__host__ __device__ __forceinline__ int perm32(int rho) { const int n = rho >> 4, i = rho & 15; return 8 * (i >> 2) + 4 * n + (i & 3); }

struct Unit { int pm, pn; };
struct Gemm { const bf16_t* A; const bf16_t* Bt; int M, N, K, lda, ldb; size_t a_pn_step; };

struct StaticOrder {
    int nM, nN, nwg, G, c;
    __host__ __device__ void init(int M, int N, int G_, int c_) { nM = M / BM; nN = N / BM; nwg = nM * nN; G = G_; c = c_; }
    __host__ __device__ bool next(int i, Unit& u) const {
        const long L = (long)i * G + c; if (L >= nwg) return false;
        int wgid = (int)L; { const int q = nwg / NXCD, r = nwg % NXCD, xcd = wgid % NXCD, off = wgid / NXCD; wgid = (xcd < r ? xcd * (q + 1) : r * (q + 1) + (xcd - r) * q) + off; }
        const int nig = WGM * nN, gid = wgid / nig, fm = gid * WGM, gsz = (nM - fm) < WGM ? (nM - fm) : WGM;
        u.pm = fm + ((wgid % nig) % gsz); u.pn = (wgid % nig) / gsz; return true;
    }
};

struct EpiBf16 {
    static constexpr bool PERM = true, AFTER_DRAIN = false;
    bf16_t* O; int ldc; const float* rope; int rope_lo, rope_hi;
    bf16_t* qkv;
    const float* rs;
    int silu_a, silu_b;
    __device__ __forceinline__ void operator()(f32x4 (&acc)[2][2][4][2], const Unit& u, int wr, int wc, int fr, int fq) const {
        const int row0 = u.pm * BM + wr * 64 + fr; const int col0 = u.pn * BM + wc * 32 + 8 * fq;
        if (rs) {
#pragma unroll
            for (int ai = 0; ai < 2; ++ai)
#pragma unroll
                for (int m = 0; m < 4; ++m) { const float r = rs[row0 + ai * HALF + m * 16];
#pragma unroll
                    for (int bj = 0; bj < 2; ++bj)
#pragma unroll
                        for (int n = 0; n < 2; ++n) acc[ai][bj][m][n] *= r; }
        }
        if (wc == 0 && u.pn >= rope_lo && u.pn < rope_hi) {
            const float sg = fq < 2 ? -1.f : 1.f;
#pragma unroll
            for (int ai = 0; ai < 2; ++ai)
#pragma unroll
                for (int m = 0; m < 4; ++m) {
                    const int pos = (row0 + ai * HALF + m * 16) & 2047;
                    const float* rp = rope + pos * 32 + 8 * (fq & 1);
                    const f32x4 c0 = *(const f32x4*)(rp), c1 = *(const f32x4*)(rp + 4), s0 = *(const f32x4*)(rp + 16) * sg, s1 = *(const f32x4*)(rp + 20) * sg;
#pragma unroll
                    for (int bj = 0; bj < 2; ++bj) {
                        f32x4 v0 = acc[ai][bj][m][0], v1 = acc[ai][bj][m][1], o0, o1;
#pragma unroll
                        for (int e = 0; e < 4; ++e) { o0[e] = lane_xor32(v0[e], fq << 4); o1[e] = lane_xor32(v1[e], fq << 4); }
                        acc[ai][bj][m][0] = v0 * c0 + o0 * s0; acc[ai][bj][m][1] = v1 * c1 + o1 * s1;
                    }
                }
        }
        const bool gate = (unsigned)(u.pn - silu_a) < 4u || (unsigned)(u.pn - silu_b) < 4u;
        const bool relay = qkv && u.pn >= 8 && u.pn < 44;
        const int hh0 = relay ? 2 * ((u.pn - 8) % 12) : 0, sh = 2 * (hh0 >> 3);
        const size_t tbase = relay ? ((size_t)((u.pn - 8) / 12) * 24 + hh0) * (size_t)(8192 * 128) : 0;
        const int ccol = qkv ? (u.pn < 8 ? u.pn * BM : 2048 + (u.pn - 44) * BM) + wc * 32 + 8 * fq : col0;
#pragma unroll
        for (int ai = 0; ai < 2; ++ai)
#pragma unroll
            for (int m = 0; m < 4; ++m) { const int row = row0 + ai * HALF + m * 16;
                bf16_t* rowp;
                if (relay) { const int p = row & 2047, r = p & ((1 << sh) - 1), l = p >> sh; rowp = qkv + tbase + (size_t)((row & ~2047) + r * (2048 >> sh) + l) * 128 + wc * 32 + 8 * fq; }
                else rowp = O + (size_t)row * ldc + ccol;
                const size_t bjstep = relay ? (size_t)(8192 * 128) : (size_t)HALF;
#pragma unroll
                for (int bj = 0; bj < 2; ++bj) { f32x4 v0 = acc[ai][bj][m][0], v1 = acc[ai][bj][m][1];
                    if (gate) {
#pragma unroll
                        for (int e = 0; e < 4; ++e) { v0[e] = silu_f(v0[e]); v1[e] = silu_f(v1[e]); } }
                    v4u w; w.x = cvt_pk_bf16(v0[0], v0[1]); w.y = cvt_pk_bf16(v0[2], v0[3]); w.z = cvt_pk_bf16(v1[0], v1[1]); w.w = cvt_pk_bf16(v1[2], v1[3]);
                    *(v4u*)(rowp + bj * bjstep) = w; }
                asm volatile("" ::: "memory"); }
    }
};
struct EpiOdd {
    static constexpr bool PERM = true, AFTER_DRAIN = false;
    bf16_t* O; int ldc; float* vpart; const float* ss2; const float* rs;
    __device__ __forceinline__ void operator()(f32x4 (&acc)[2][2][4][2], const Unit& u, int wr, int wc, int fr, int fq) const {
        const int row0 = u.pm * BM + wr * 64 + fr; const int cw = wc * 32 + 8 * fq;
#pragma unroll
        for (int ai = 0; ai < 2; ++ai)
#pragma unroll
            for (int m = 0; m < 4; ++m) { const int row = row0 + ai * HALF + m * 16; float r;
                if (ss2) { const f32x4 a = *(const f32x4*)(ss2 + (size_t)row * 8), b = *(const f32x4*)(ss2 + (size_t)row * 8 + 4); r = 1.f / sqrtf((((a[0] + a[1]) + (a[2] + a[3])) + ((b[0] + b[1]) + (b[2] + b[3]))) * (1.f / 2048.f) + 1e-6f); }
                else r = rs[row];
#pragma unroll
                for (int bj = 0; bj < 2; ++bj)
#pragma unroll
                    for (int n = 0; n < 2; ++n) acc[ai][bj][m][n] *= r; }
        const bool pair = u.pn < 8 || (u.pn >= 12 && u.pn < 20);
        if (pair) {
            const bool glu = u.pn >= 12; const int col0 = (glu ? 2048 + 128 * (u.pn - 12) : 128 * u.pn) + cw;
#pragma unroll
            for (int ai = 0; ai < 2; ++ai)
#pragma unroll
                for (int m = 0; m < 4; ++m) {
                    f32x4 o[2];
#pragma unroll
                    for (int n = 0; n < 2; ++n)
#pragma unroll
                        for (int e = 0; e < 4; ++e) { const float a = acc[ai][0][m][n][e], g = acc[ai][1][m][n][e]; const float sg = sigmoid_f(g); o[n][e] = glu ? a * sg : a * g * sg; }
                    v4u w; w.x = cvt_pk_bf16(o[0][0], o[0][1]); w.y = cvt_pk_bf16(o[0][2], o[0][3]); w.z = cvt_pk_bf16(o[1][0], o[1][1]); w.w = cvt_pk_bf16(o[1][2], o[1][3]);
                    *(v4u*)(O + (size_t)(row0 + ai * HALF + m * 16) * ldc + col0) = w;
                    asm volatile("" ::: "memory");
                }
        } else {
            if (u.pn < 12) {
#pragma unroll
                for (int ai = 0; ai < 2; ++ai)
#pragma unroll
                    for (int m = 0; m < 4; ++m) {
                        float s1 = 0.f, s2 = 0.f;
#pragma unroll
                        for (int bj = 0; bj < 2; ++bj)
#pragma unroll
                            for (int n = 0; n < 2; ++n)
#pragma unroll
                                for (int e = 0; e < 4; ++e) { const float v = acc[ai][bj][m][n][e]; s1 += v; s2 += v * v; }
                        s1 += lane_xor16(s1, fq << 4); s2 += lane_xor16(s2, fq << 4); s1 += lane_xor32(s1, fq << 4); s2 += lane_xor32(s2, fq << 4);
                        if (fq == 0) *(f32x2*)(vpart + ((size_t)(row0 + ai * HALF + m * 16) * 16 + (u.pn - 8) * 4 + wc) * 2) = (f32x2){s1, s2};
                    }
            }
            const bool gate = u.pn >= 20; const int col0 = (gate ? 3072 + 256 * (u.pn - 20) : 1024 + 256 * (u.pn - 8)) + cw;
#pragma unroll
            for (int ai = 0; ai < 2; ++ai)
#pragma unroll
                for (int m = 0; m < 4; ++m) { bf16_t* rowp = O + (size_t)(row0 + ai * HALF + m * 16) * ldc + col0;
#pragma unroll
                    for (int bj = 0; bj < 2; ++bj) { f32x4 v0 = acc[ai][bj][m][0], v1 = acc[ai][bj][m][1];
                        if (gate) {
#pragma unroll
                            for (int e = 0; e < 4; ++e) { v0[e] = silu_f(v0[e]); v1[e] = silu_f(v1[e]); } }
                        v4u w; w.x = cvt_pk_bf16(v0[0], v0[1]); w.y = cvt_pk_bf16(v0[2], v0[3]); w.z = cvt_pk_bf16(v1[0], v1[1]); w.w = cvt_pk_bf16(v1[2], v1[3]);
                        *(v4u*)(rowp + bj * HALF) = w; }
                    asm volatile("" ::: "memory"); }
        }
    }
};
struct EpiF32 {
    static constexpr bool PERM = false;
    float* O; int ldc;
    __device__ __forceinline__ void operator()(const f32x4 (&acc)[2][2][4][2], const Unit& u, int wr, int wc, int fr, int fq) const {
        const int row0 = u.pm * BM + wr * 64 + fr; const int col0 = u.pn * BM + wc * 32 + 4 * fq;
#pragma unroll
        for (int ai = 0; ai < 2; ++ai)
#pragma unroll
            for (int m = 0; m < 4; ++m) { float* rowp = O + (size_t)(row0 + ai * HALF + m * 16) * ldc + col0;
#pragma unroll
                for (int bj = 0; bj < 2; ++bj)
#pragma unroll
                    for (int n = 0; n < 2; ++n) *(f32x4*)(rowp + bj * HALF + n * 16) = acc[ai][bj][m][n]; }
    }
};
struct EpiPool {
    static constexpr bool PERM = true, AFTER_DRAIN = false;
    bf16_t* O; int ldc; const bf16_t* gate; int ldg; const float* scale;
    __device__ __forceinline__ void operator()(const f32x4 (&acc)[2][2][4][2], const Unit& u, int wr, int wc, int fr, int fq) const {
        const int row0 = u.pm * BM + wr * 64 + fr; const int col0 = u.pn * BM + wc * 32 + 8 * fq;
#pragma unroll
        for (int bj = 0; bj < 2; ++bj) {
            const f32x4 s0 = *(const f32x4*)(scale + col0 + bj * HALF), s1 = *(const f32x4*)(scale + col0 + bj * HALF + 4);
#pragma unroll
            for (int ai = 0; ai < 2; ++ai)
#pragma unroll
                for (int m = 0; m < 4; ++m) { const size_t row = (size_t)(row0 + ai * HALF + m * 16);
                    const v4u gv = *(const v4u*)(gate + row * ldg + col0 + bj * HALF);
                    const f32x4 v0 = acc[ai][bj][m][0], v1 = acc[ai][bj][m][1];
                    v4u w;
                    w.x = cvt_pk_bf16(v0[0] * s0[0] * bflo(gv.x), v0[1] * s0[1] * bfhi(gv.x));
                    w.y = cvt_pk_bf16(v0[2] * s0[2] * bflo(gv.y), v0[3] * s0[3] * bfhi(gv.y));
                    w.z = cvt_pk_bf16(v1[0] * s1[0] * bflo(gv.z), v1[1] * s1[1] * bfhi(gv.z));
                    w.w = cvt_pk_bf16(v1[2] * s1[2] * bflo(gv.w), v1[3] * s1[3] * bfhi(gv.w));
                    *(v4u*)(O + row * ldc + col0 + bj * HALF) = w;
                    if (m & 1) asm volatile("" ::: "memory"); }
        }
    }
};

template <class Epi, bool ALIGN_EPI>
__device__ __forceinline__ void gemm_phase(LAS unsigned char* lds, const Gemm g, const StaticOrder& S, const Epi& E) {
    const int tid = threadIdx.x, wid = __builtin_amdgcn_readfirstlane(tid >> 6), lane = tid & 63, wr = wid >> 2, wc = wid & 3, fr = lane & 15, fq = lane >> 4;
    const int K = g.K, nt = K / BK;
    unsigned voffA[2], voffB[2];
#pragma unroll
    for (int i = 0; i < 2; ++i) { int R, C; stage_rc(tid * 16 + i * 8192, R, C); const int Rb = Epi::PERM ? ((R & ~31) + perm32(R & 31)) : R;
        voffA[i] = (unsigned)(R * g.lda + C) * 2u; voffB[i] = (unsigned)(Rb * g.ldb + C) * 2u; }
    const size_t kstep = (size_t)(BK * 2);
    const size_t hstepA = (size_t)HALF * g.lda * 2, hstepB = (size_t)HALF * g.ldb * 2;
    const size_t tstepA = 2 * hstepA, tstepB = 2 * hstepB;
    const unsigned ldsw = (unsigned)wid * 1024u;
    const int aoff = lds_byte(wr * 64 + fr, fq * 8), boff = lds_byte(wc * 32 + fr, fq * 8);
#define PG8_SA(b, h) (((b) * 2 + (h)) * HTB)
#define PG8_SB(b, h) ((4 + (b) * 2 + (h)) * HTB)
#define PG8_STAGE(bufoff, gbase, voff) do { const char* gb_ = (const char*)(gbase); asm volatile("" : "+s"(gb_));   \
        _Pragma("unroll") for (int _i = 0; _i < 2; ++_i) \
        __builtin_amdgcn_global_load_lds((const unsigned*)(gb_ + (voff)[_i]), (LAS unsigned*)(lds + (bufoff) + ldsw + _i * 8192), 16, 0, 0); } while (0)
#define PG8_LDA(dst, b, h) do { _Pragma("unroll") for (int m = 0; m < 4; ++m) _Pragma("unroll") for (int k = 0; k < 2; ++k) dst[m][k] = *(const LAS bf16x8*)(lds + PG8_SA(b, h) + aoff + m * 2048 + k * 1024); } while (0)
#define PG8_LDB(dst, b, h) do { _Pragma("unroll") for (int n = 0; n < 2; ++n) _Pragma("unroll") for (int k = 0; k < 2; ++k) dst[n][k] = *(const LAS bf16x8*)(lds + PG8_SB(b, h) + boff + n * 2048 + k * 1024); } while (0)
#define PG8_MMA(ai, bj, At, Bt) do { __builtin_amdgcn_s_setprio(1); _Pragma("unroll") for (int m = 0; m < 4; ++m) _Pragma("unroll") for (int n = 0; n < 2; ++n) _Pragma("unroll") for (int k = 0; k < 2; ++k) \
        acc[ai][bj][m][n] = __builtin_amdgcn_mfma_f32_16x16x32_bf16(Bt[n][k], At[m][k], acc[ai][bj][m][n], 0, 0, 0); __builtin_amdgcn_s_setprio(0); } while (0)
#define PG8_WAIT_V(n) asm volatile("s_waitcnt vmcnt(" #n ")" ::: "memory")
#define PG8_WAIT_L(n) asm volatile("s_waitcnt lgkmcnt(" #n ")" ::: "memory")
#define PG8_BAR __builtin_amdgcn_s_barrier()
#define PG8_SCHED __builtin_amdgcn_sched_barrier(0)
    Unit cur, nxt; int ui = 0;
    if (!S.next(0, cur)) return;
    f32x4 acc[2][2][4][2];
#pragma unroll
    for (int a = 0; a < 2; ++a)
#pragma unroll
        for (int b = 0; b < 2; ++b)
#pragma unroll
            for (int m = 0; m < 4; ++m)
#pragma unroll
                for (int n = 0; n < 2; ++n) acc[a][b][m][n] = (f32x4){0.f, 0.f, 0.f, 0.f};
    bf16x8 At[4][2], B0[2][2], B1[2][2];
    const char* cA = (const char*)g.A + (size_t)cur.pm * tstepA + (size_t)cur.pn * g.a_pn_step; const char* cB = (const char*)g.Bt + (size_t)cur.pn * tstepB;
    PG8_STAGE(PG8_SB(0, 0), cB, voffB); PG8_STAGE(PG8_SB(0, 1), cB + hstepB, voffB); PG8_STAGE(PG8_SA(0, 0), cA, voffA); PG8_STAGE(PG8_SA(0, 1), cA + hstepA, voffA);
    if (wr == 1) PG8_BAR;
    PG8_WAIT_V(2); PG8_BAR;
    PG8_STAGE(PG8_SB(1, 0), cB + kstep, voffB); PG8_STAGE(PG8_SA(1, 0), cA + kstep, voffA); PG8_STAGE(PG8_SB(1, 1), cB + hstepB + kstep, voffB);
    PG8_WAIT_V(6); PG8_BAR;
    for (;;) {
        const bool has_next = S.next(ui + 1, nxt);
        const char* nA = has_next ? (const char*)g.A + (size_t)nxt.pm * tstepA + (size_t)nxt.pn * g.a_pn_step : cA; const char* nB = has_next ? (const char*)g.Bt + (size_t)nxt.pn * tstepB : cB;
        for (int t = 0; t < nt; t += 2) {
            const bool last = (t == nt - 2);
            const char* a1 = cA + (size_t)(t + 1) * kstep;
            const char* a2 = last ? nA : cA + (size_t)(t + 2) * kstep; const char* b2 = last ? nB : cB + (size_t)(t + 2) * kstep;
            const char* a3 = a2 + kstep; const char* b3 = b2 + kstep;
            PG8_LDB(B0, 0, 0); PG8_LDB(B1, 0, 1); PG8_SCHED; PG8_LDA(At, 0, 0); PG8_STAGE(PG8_SA(1, 1), a1 + hstepA, voffA);
            PG8_WAIT_V(8); PG8_WAIT_L(0); PG8_BAR; PG8_MMA(0, 0, At, B0); PG8_MMA(0, 1, At, B1); PG8_BAR; PG8_SCHED;
            PG8_LDA(At, 0, 1); PG8_STAGE(PG8_SB(0, 0), b2, voffB); PG8_STAGE(PG8_SB(0, 1), b2 + hstepB, voffB); PG8_STAGE(PG8_SA(0, 0), a2, voffA);
            PG8_WAIT_V(8); PG8_WAIT_L(0); PG8_BAR; PG8_MMA(1, 0, At, B0); PG8_MMA(1, 1, At, B1); PG8_BAR; PG8_SCHED;
            PG8_LDB(B0, 1, 0); PG8_LDB(B1, 1, 1); PG8_SCHED; PG8_LDA(At, 1, 0); PG8_STAGE(PG8_SA(0, 1), a2 + hstepA, voffA);
            PG8_WAIT_V(8); PG8_WAIT_L(0); PG8_BAR; PG8_MMA(0, 0, At, B0); PG8_MMA(0, 1, At, B1); PG8_BAR; PG8_SCHED;
            PG8_LDA(At, 1, 1); PG8_STAGE(PG8_SB(1, 0), b3, voffB); PG8_STAGE(PG8_SB(1, 1), b3 + hstepB, voffB); PG8_STAGE(PG8_SA(1, 0), a3, voffA);
            PG8_WAIT_V(8); PG8_WAIT_L(0); PG8_BAR; PG8_MMA(1, 0, At, B0); PG8_MMA(1, 1, At, B1); PG8_BAR; PG8_SCHED;
        }
        if constexpr (ALIGN_EPI) { if (wr == 0) PG8_BAR; }
        if constexpr (!Epi::AFTER_DRAIN) E(acc, cur, wr, wc, fr, fq);
        if (!has_next) break;
#pragma unroll
        for (int a = 0; a < 2; ++a)
#pragma unroll
            for (int b = 0; b < 2; ++b)
#pragma unroll
                for (int m = 0; m < 4; ++m)
#pragma unroll
                    for (int n = 0; n < 2; ++n) acc[a][b][m][n] = (f32x4){0.f, 0.f, 0.f, 0.f};
        cur = nxt; cA = nA; cB = nB; ++ui;
        if constexpr (ALIGN_EPI) { if (wr == 1) PG8_BAR; }
    }
    PG8_WAIT_V(0);
    if constexpr (!ALIGN_EPI) { if (wr == 0) PG8_BAR; }
    PG8_BAR;
    if constexpr (Epi::AFTER_DRAIN) E.fused(acc, cur, wr, wc, fr, fq, lds, tid, lane);
#undef PG8_SA
#undef PG8_SB
#undef PG8_STAGE
#undef PG8_LDA
#undef PG8_LDB
#undef PG8_MMA
#undef PG8_WAIT_V
#undef PG8_WAIT_L
#undef PG8_BAR
#undef PG8_SCHED
}
}

constexpr int NWAVES = 8, NTHREADS = 512;
constexpr int DM = 2048, SEQ = 2048, NB = 4, MTOK = NB * SEQ;
constexpr int EIN = 12288, OIN = 6144;
constexpr int ZGP = 3072, ZG_AIN = 0, ZG_AGATE = 1024, ZG_BGATE = 2048;
constexpr int ZC_AIN = 0, ZC_AGATE = 1024, ZC_Q = 2048, ZC_K = 5120, ZC_V = 8192, ZC_BGATE = 11264;
constexpr int O2 = 4096, OC_UG = 0, OC_V = 1024, OC_DD = 2048, OC_DG = 3072;
constexpr float EPS = 1e-6f;

constexpr size_t MiB = 1u << 20;
constexpr size_t WS_W1 = 1 * MiB;
constexpr size_t WS_OG = WS_W1;
constexpr size_t WS_W2 = 49 * MiB;
constexpr size_t WS_W3 = 57 * MiB;
constexpr size_t WS_W4 = 81 * MiB;
constexpr size_t WS_PW = 89 * MiB;
constexpr size_t WS_SGW = WS_PW + 512 * 1024;
constexpr size_t WS_ROPE = WS_SGW + 128 * 1024;
constexpr size_t WS_LSE = 90 * MiB;
constexpr size_t WS_XN = 91 * MiB;
constexpr size_t WS_MIX = WS_XN;
constexpr size_t WS_Z = 123 * MiB;
constexpr size_t WS_Y = WS_Z;
constexpr size_t WS_ZG = WS_Z, WS_Q = WS_Z + 48 * MiB, WS_K = WS_Z + 96 * MiB, WS_V = WS_Z + 144 * MiB;
constexpr size_t WS_Z1 = WS_Z + 64 * MiB;
constexpr size_t WS_X1B = WS_Z + 32 * MiB;
constexpr size_t WS_R1 = WS_LSE + 800 * 1024;
constexpr size_t WS_POOLED = 315 * MiB;
constexpr size_t WS_VPART = WS_POOLED;
constexpr size_t WS_XB = 331 * MiB;
constexpr size_t WS_R0 = WS_R1 + 32 * 1024;
constexpr size_t WS_SS = WS_POOLED + 2 * MiB;
constexpr size_t WS_SS2 = WS_POOLED + 3 * MiB;
constexpr size_t WS_END = 363 * MiB;

constexpr int LDS_BYTES = 147456;


#define XB_TMO      128
#define XB_XCNT(j)  (256  + 64 * (j))
#define XB_XSUB(j)  (1280 + 64 * (j))
#define XB_XGEN(j)  (2304 + 64 * (j))
#define XB_TOP      3328
#define XB_TOPGEN   3392
#define XCD_BAR_WORDS 3456
#define XB_SPIN_CAP (1u << 18)
__device__ __forceinline__ unsigned xb_ld(unsigned* p)              { return __hip_atomic_load(p, __ATOMIC_RELAXED, __HIP_MEMORY_SCOPE_AGENT); }
__device__ __forceinline__ unsigned xb_add(unsigned* p, unsigned v) { return __hip_atomic_fetch_add(p, v, __ATOMIC_RELAXED, __HIP_MEMORY_SCOPE_AGENT); }
__device__ __forceinline__ unsigned xb_xcc_id() { return (unsigned)__builtin_amdgcn_s_getreg((3 << 11) | 20) & 0xFu; }
#define XB_SPIN(cond, bar) do { unsigned _sp = 0; while (cond) { __builtin_amdgcn_s_sleep(1); \
    if ((++_sp & 255u) == 0u) { if (xb_ld(&(bar)[XB_TMO])) break; if (_sp > XB_SPIN_CAP) { atomicAdd(&(bar)[XB_TMO], 1u); break; } } } } while (0)
struct XcdBarrier { unsigned* bar; unsigned x; volatile LAS unsigned* st; };
__device__ __forceinline__ XcdBarrier xcd_barrier_post(unsigned* bar, volatile LAS unsigned* st) {
    XcdBarrier b; b.bar = bar; b.x = xb_xcc_id(); b.st = st;
    if (threadIdx.x == 0) (void)xb_add(&bar[XB_XCNT(b.x)], 1u);
    return b;
}
__device__ __forceinline__ void xcd_barrier_complete(unsigned* bar, unsigned x, unsigned& nloc, unsigned& nx) {
    const unsigned G = gridDim.x * gridDim.y * gridDim.z;
    unsigned sum, cnt, mine, sp = 0u;
    for (;;) {
        sum = 0u; cnt = 0u; mine = 0u;
#pragma unroll
        for (unsigned j = 0; j < 16; ++j) { const unsigned c = xb_ld(&bar[XB_XCNT(j)]); sum += c; cnt += (c > 0u) ? 1u : 0u; mine = (j == x) ? c : mine; }
        if (sum == G) break;
        __builtin_amdgcn_s_sleep(1);
        if ((++sp & 255u) == 0u) { if (xb_ld(&bar[XB_TMO])) break; if (sp > XB_SPIN_CAP) { atomicAdd(&bar[XB_TMO], 1u); break; } }
    }
    nloc = mine > 0u ? mine : 1u; nx = cnt > 0u ? cnt : 1u;
}
__device__ __forceinline__ void xcd_barrier(const XcdBarrier& b) {
    asm volatile("s_waitcnt vmcnt(0)" ::: "memory");
    __syncthreads();
    if (threadIdx.x == 0) {
        unsigned* bar = b.bar;
        __builtin_amdgcn_s_waitcnt(0);
        unsigned nloc = b.st[0], nx = b.st[1];
        if (nloc == 0u) { xcd_barrier_complete(bar, b.x, nloc, nx); b.st[0] = nloc; b.st[1] = nx; }
        const unsigned old = xb_add(&bar[XB_XSUB(b.x)], 1u);
        const unsigned gen = old / nloc;
        if (old + 1u == (gen + 1u) * nloc) {
            __builtin_amdgcn_fence(__ATOMIC_RELEASE, "agent");
            asm volatile("s_waitcnt vmcnt(0)" ::: "memory");
            const unsigned og = xb_add(&bar[XB_TOP], 1u);
            const unsigned tg = og / nx;
            if (og + 1u == (tg + 1u) * nx) xb_add(&bar[XB_TOPGEN], 1u);
            else XB_SPIN(xb_ld(&bar[XB_TOPGEN]) == tg, bar);
            __builtin_amdgcn_fence(__ATOMIC_ACQUIRE, "agent");
            xb_add(&bar[XB_XGEN(b.x)], 1u);
            asm volatile("s_waitcnt vmcnt(0)" ::: "memory");
        } else {
            XB_SPIN(xb_ld(&bar[XB_XGEN(b.x)]) == gen, bar);
            __builtin_amdgcn_fence(__ATOMIC_ACQUIRE, "agent");
            asm volatile("s_waitcnt vmcnt(0)" ::: "memory");
        }
    }
    __syncthreads();
}

struct EpiFinal {
    static constexpr bool PERM = true, AFTER_DRAIN = true;
    const bf16* X1; float* out; const float* gpost; float* ss; XcdBarrier bar;
    __device__ __forceinline__ void fused(f32x4 (&acc)[2][2][4][2], const pg8::Unit& u, int wr, int wc, int fr, int fq, LAS unsigned char* lds, int tid, int lane) const {
        LAS float* P = (LAS float*)lds;
        v4u xpre[1][4][2];
#pragma unroll
        for (int ai = 0; ai < 1; ++ai)
#pragma unroll
            for (int m = 0; m < 4; ++m)
#pragma unroll
                for (int bj = 0; bj < 2; ++bj) xpre[ai][m][bj] = *(const v4u*)(X1 + (size_t)(u.pm * 256 + wr * 64 + fr + ai * 128 + m * 16) * DM + u.pn * 256 + bj * 128 + wc * 32 + 8 * fq);
#pragma unroll
        for (int ai = 0; ai < 2; ++ai)
#pragma unroll
            for (int m = 0; m < 4; ++m) {
                float sq = 0.f;
#pragma unroll
                for (int bj = 0; bj < 2; ++bj)
#pragma unroll
                    for (int n = 0; n < 2; ++n) { const f32x4 v = acc[ai][bj][m][n]; sq += (v[0] * v[0] + v[1] * v[1]) + (v[2] * v[2] + v[3] * v[3]); }
                sq += lane_xor16(sq, fq << 4); sq += lane_xor32(sq, fq << 4);
                if (fq == 0) P[(ai * 128 + wr * 64 + m * 16 + fr) * 4 + wc] = sq;
            }
        __syncthreads();
        if (tid < 256) { const f32x4 p = *(const LAS f32x4*)(P + tid * 4); ss[((size_t)u.pm * 256 + tid) * 8 + u.pn] = (p[0] + p[1]) + (p[2] + p[3]); }
        xcd_barrier(bar);
        const int row0 = u.pm * 256 + wr * 64 + fr;
#pragma unroll
        for (int ai = 0; ai < 2; ++ai)
#pragma unroll
            for (int m = 0; m < 4; ++m) {
                const size_t row = (size_t)(row0 + ai * 128 + m * 16);
                const f32x4 a = *(const f32x4*)(ss + row * 8), b = *(const f32x4*)(ss + row * 8 + 4);
                const float r = 1.f / sqrtf((((a[0] + a[1]) + (a[2] + a[3])) + ((b[0] + b[1]) + (b[2] + b[3]))) * (1.f / DM) + EPS);
#pragma unroll
                for (int bj = 0; bj < 2; ++bj) {
                    const int col0 = u.pn * 256 + bj * 128 + wc * 32 + 8 * fq;
                    const v4u xb = ai == 0 ? xpre[0][m][bj] : *(const v4u*)(X1 + row * DM + col0);
                    const f32x4 g0 = *(const f32x4*)(gpost + col0), g1 = *(const f32x4*)(gpost + col0 + 4);
                    const f32x4 o0 = (f32x4){bflo(xb.x), bfhi(xb.x), bflo(xb.y), bfhi(xb.y)} + acc[ai][bj][m][0] * r * g0;
                    const f32x4 o1 = (f32x4){bflo(xb.z), bfhi(xb.z), bflo(xb.w), bfhi(xb.w)} + acc[ai][bj][m][1] * r * g1;
                    *(f32x4*)(out + row * DM + col0) = o0; *(f32x4*)(out + row * DM + col0 + 4) = o1;
                }
                asm volatile("" ::: "memory");
            }
    }
};

struct EpiMid {
    static constexpr bool PERM = true, AFTER_DRAIN = true;
    const bf16* XB; bf16* X1; const float* gpost; float* ss; float* ss2; XcdBarrier bar;
    __device__ __forceinline__ void fused(f32x4 (&acc)[2][2][4][2], const pg8::Unit& u, int wr, int wc, int fr, int fq, LAS unsigned char* lds, int tid, int lane) const {
        LAS float* P = (LAS float*)lds;
        v4u xpre[1][4][2];
#pragma unroll
        for (int ai = 0; ai < 1; ++ai)
#pragma unroll
            for (int m = 0; m < 4; ++m)
#pragma unroll
                for (int bj = 0; bj < 2; ++bj) xpre[ai][m][bj] = *(const v4u*)(XB + (size_t)(u.pm * 256 + wr * 64 + fr + ai * 128 + m * 16) * DM + u.pn * 256 + bj * 128 + wc * 32 + 8 * fq);
#pragma unroll
        for (int ai = 0; ai < 2; ++ai)
#pragma unroll
            for (int m = 0; m < 4; ++m) {
                float sq = 0.f;
#pragma unroll
                for (int bj = 0; bj < 2; ++bj)
#pragma unroll
                    for (int n = 0; n < 2; ++n) { const f32x4 v = acc[ai][bj][m][n]; sq += (v[0] * v[0] + v[1] * v[1]) + (v[2] * v[2] + v[3] * v[3]); }
                sq += lane_xor16(sq, fq << 4); sq += lane_xor32(sq, fq << 4);
                if (fq == 0) P[(ai * 128 + wr * 64 + m * 16 + fr) * 4 + wc] = sq;
            }
        __syncthreads();
        if (tid < 256) { const f32x4 p = *(const LAS f32x4*)(P + tid * 4); ss[((size_t)u.pm * 256 + tid) * 8 + u.pn] = (p[0] + p[1]) + (p[2] + p[3]); }
        xcd_barrier(bar);
        const int row0 = u.pm * 256 + wr * 64 + fr;
#pragma unroll
        for (int ai = 0; ai < 2; ++ai)
#pragma unroll
            for (int m = 0; m < 4; ++m) {
                const size_t row = (size_t)(row0 + ai * 128 + m * 16);
                const f32x4 a = *(const f32x4*)(ss + row * 8), b = *(const f32x4*)(ss + row * 8 + 4);
                const float r = 1.f / sqrtf((((a[0] + a[1]) + (a[2] + a[3])) + ((b[0] + b[1]) + (b[2] + b[3]))) * (1.f / DM) + EPS);
                float sq = 0.f;
#pragma unroll
                for (int bj = 0; bj < 2; ++bj) {
                    const int col0 = u.pn * 256 + bj * 128 + wc * 32 + 8 * fq;
                    const v4u xb = ai == 0 ? xpre[0][m][bj] : *(const v4u*)(XB + row * DM + col0);
                    const f32x4 g0 = *(const f32x4*)(gpost + col0), g1 = *(const f32x4*)(gpost + col0 + 4);
                    const f32x4 o0 = (f32x4){bflo(xb.x), bfhi(xb.x), bflo(xb.y), bfhi(xb.y)} + acc[ai][bj][m][0] * r * g0;
                    const f32x4 o1 = (f32x4){bflo(xb.z), bfhi(xb.z), bflo(xb.w), bfhi(xb.w)} + acc[ai][bj][m][1] * r * g1;
                    sq += ((o0[0] * o0[0] + o0[1] * o0[1]) + (o0[2] * o0[2] + o0[3] * o0[3])) + ((o1[0] * o1[0] + o1[1] * o1[1]) + (o1[2] * o1[2] + o1[3] * o1[3]));
                    v4u w; w.x = cvt_pk_bf16(o0[0], o0[1]); w.y = cvt_pk_bf16(o0[2], o0[3]); w.z = cvt_pk_bf16(o1[0], o1[1]); w.w = cvt_pk_bf16(o1[2], o1[3]);
                    *(v4u*)(X1 + row * DM + col0) = w;
                }
                sq += lane_xor16(sq, fq << 4); sq += lane_xor32(sq, fq << 4);
                if (fq == 0) P[(ai * 128 + wr * 64 + m * 16 + fr) * 4 + wc] = sq;
                asm volatile("" ::: "memory");
            }
        __syncthreads();
        if (tid < 256) { const f32x4 p = *(const LAS f32x4*)(P + tid * 4); ss2[((size_t)u.pm * 256 + tid) * 8 + u.pn] = (p[0] + p[1]) + (p[2] + p[3]); }
    }
};

struct TrItem { const float* src; bf16* dst; int N, K; const float* gk; };
__device__ __forceinline__ void p0_tr_load(const TrItem& t, float (&v)[32], int lane) {
#pragma unroll
    for (int i = 0; i < 32; ++i) v[i] = __builtin_nontemporal_load(t.src + (size_t)(2 * i + (lane >> 5)) * t.N + (lane & 31));
}
__device__ __forceinline__ void p0_tr_store(const TrItem& t, const float (&v)[32], LAS float* scr, int lane) {
#pragma unroll
    for (int i = 0; i < 32; ++i) scr[(2 * i + (lane >> 5)) * 33 + (lane & 31)] = v[i];
    asm volatile("s_waitcnt lgkmcnt(0)" ::: "memory");
    const int c = lane & 7;
    f32x4 g0 = (f32x4){1.f, 1.f, 1.f, 1.f}, g1 = g0;
    if (t.gk) { g0 = *(const f32x4*)(t.gk + 8 * c); g1 = *(const f32x4*)(t.gk + 8 * c + 4); }
#pragma unroll
    for (int j = 0; j < 4; ++j) { const int n = (lane >> 3) + 8 * j; const LAS float* sp = scr + (8 * c) * 33 + n;
        v4u o; o.x = cvt_pk_bf16(sp[0 * 33] * g0[0], sp[1 * 33] * g0[1]); o.y = cvt_pk_bf16(sp[2 * 33] * g0[2], sp[3 * 33] * g0[3]); o.z = cvt_pk_bf16(sp[4 * 33] * g1[0], sp[5 * 33] * g1[1]); o.w = cvt_pk_bf16(sp[6 * 33] * g1[2], sp[7 * 33] * g1[3]);
        *(v4u*)(t.dst + (size_t)n * t.K + 8 * c) = o; }
    asm volatile("s_waitcnt lgkmcnt(0)" ::: "memory");
}
__device__ __forceinline__ void rows2_to_bf16_rms(const float* x0, const float* x1, bf16* o0, bf16* o1, float* r0, float* r1, int lane) {
    const f32x4* xa = (const f32x4*)x0 + lane; const f32x4* xb = (const f32x4*)x1 + lane;
    f32x4 va[8], vb[8]; float sa = 0.f, sb = 0.f;
#pragma unroll
    for (int j = 0; j < 8; ++j) { va[j] = __builtin_nontemporal_load(xa + 64 * j); vb[j] = __builtin_nontemporal_load(xb + 64 * j); }
#pragma unroll
    for (int j = 0; j < 8; ++j) { sa += (va[j].x * va[j].x + va[j].y * va[j].y) + (va[j].z * va[j].z + va[j].w * va[j].w); sb += (vb[j].x * vb[j].x + vb[j].y * vb[j].y) + (vb[j].z * vb[j].z + vb[j].w * vb[j].w); }
    sa = wave_sum(sa); sb = wave_sum(sb);
    if (lane == 0) { *r0 = 1.f / sqrtf(sa * (1.f / DM) + EPS); *r1 = 1.f / sqrtf(sb * (1.f / DM) + EPS); }
    v2u* pa = (v2u*)o0 + lane; v2u* pb = (v2u*)o1 + lane;
#pragma unroll
    for (int j = 0; j < 8; ++j) {
        v2u w; w.x = cvt_pk_bf16(va[j].x, va[j].y); w.y = cvt_pk_bf16(va[j].z, va[j].w); pa[64 * j] = w;
        v2u u; u.x = cvt_pk_bf16(vb[j].x, vb[j].y); u.y = cvt_pk_bf16(vb[j].z, vb[j].w); pb[64 * j] = u; }
}

typedef short s16x4 __attribute__((ext_vector_type(4)));
constexpr int KP = 136;
constexpr int VP = 144;
static_assert(2 * 128 * KP * 2 + 2 * 128 * VP * 2 <= LDS_BYTES - 16, "attention LDS");

constexpr int KT_BYTES = 128 * KP * 2, VT_BYTES = 128 * VP * 2;
struct AttStep { int d, r, qt, hh, b, L; int g, h; };
__device__ __forceinline__ AttStep att_decode(int step) {
    AttStep a; const int g = step >> 9, w = step & 511;
    const int nl = 4 - 2 * g, dl = 2 * g;
    const int qt = w & ((1 << nl) - 1), seq = w >> nl, r = seq & ((1 << dl) - 1), bh = seq >> dl;
    const int b = bh >> 3, h = bh & 7;
    a.d = 1 << dl; a.r = r; a.qt = qt; a.g = g; a.h = h; a.hh = g * 8 + h; a.b = b; a.L = SEQ >> dl; return a;
}
__device__ __forceinline__ void att_load_tile(const bf16* Z, const AttStep& a, int tile, int tid, v4u (&kv)[4], v4u (&vv)[4]) {
    const int kl = tid >> 4, ch = tid & 15;
    const bf16* base = Z + ((size_t)a.hh * 8192 + (a.b << 11) + a.r * a.L + 128 * tile + kl) * 128 + 8 * ch;
#pragma unroll
    for (int ps = 0; ps < 4; ++ps) { kv[ps] = *(const v4u*)(base + (size_t)(WS_K - WS_Q) / 2 + ps * 32 * 128); vv[ps] = *(const v4u*)(base + (size_t)(WS_V - WS_Q) / 2 + ps * 32 * 128); }
}
__device__ __forceinline__ void att_store_tile(LAS unsigned char* kbuf, LAS unsigned char* vbuf, int tid, const v4u (&kv)[4], const v4u (&vv)[4]) {
    const int kl = tid >> 4, ch = tid & 15;
#pragma unroll
    for (int ps = 0; ps < 4; ++ps) { const int kk = ps * 32 + kl; *(LAS v4u*)((LAS bf16*)kbuf + kk * KP + 8 * ch) = kv[ps]; *(LAS v4u*)((LAS bf16*)vbuf + kk * VP + 8 * ch) = vv[ps]; }
}
__device__ __forceinline__ void att_load_q(const bf16* Z, const AttStep& a, int wave, int lane, bf16x8 (&qf)[4]) {
    const bf16* qp = Z + ((size_t)a.hh * 8192 + (a.b << 11) + a.r * a.L + 128 * a.qt + 16 * wave + (lane & 15)) * 128 + 8 * (lane >> 4);
#pragma unroll
    for (int ks = 0; ks < 4; ++ks) qf[ks] = *(const bf16x8*)(qp + 32 * ks);
}
__device__ __forceinline__ void attn_phase(LAS unsigned char* lds, const bf16* Z, bf16* OG, float* LSE, int s0, int s1, int tid, int lane, int wave) {
    if (s0 >= s1) return;
    const int quad = lane >> 4;
    int par = 0;
    int s0v = s0; asm volatile("" : "+v"(s0v));
    AttStep cur = att_decode(s0v);
    int cur_qt = __builtin_amdgcn_readfirstlane(cur.qt);
    bf16x8 qf[4];
    {
        v4u kv[4], vv[4], kp[4], vp[4];
        att_load_tile(Z, cur, cur.qt, tid, kv, vv);
        if (cur_qt > 0) att_load_tile(Z, cur, cur.qt - 1, tid, kp, vp);
        att_load_q(Z, cur, wave, lane, qf);
        att_store_tile(lds, lds + 2 * KT_BYTES, tid, kv, vv);
        if (cur_qt > 0) att_store_tile(lds + KT_BYTES, lds + 2 * KT_BYTES + VT_BYTES, tid, kp, vp);
    }
    for (int step = s0; step < s1; ++step) {
        const bool has_next = step + 1 < s1;
        AttStep nxt = cur; v4u nkv[4], nvv[4]; bf16x8 nqf[4];
        if (has_next) { int sv = step + 1; asm volatile("" : "+v"(sv)); nxt = att_decode(sv); att_load_tile(Z, nxt, nxt.qt, tid, nkv, nvv); att_load_q(Z, nxt, wave, lane, nqf); }
        __syncthreads();
        const bool has_prev = cur_qt > 0;
        const int qq = 16 * wave + (lane & 15);
        const int np = has_prev ? 8 - wave : 0;
        int kaddr[9], vaddr[9], krel[9];
#pragma unroll
        for (int i = 0; i < 9; ++i) {
            const bool isp = i < np; const int c = i - np; const bool dummy = !isp && c >= 8;
            const int kt = isp ? wave + i : (dummy ? 0 : c);
            const int slot = isp ? (par ^ 1) : par;
            kaddr[i] = slot * KT_BYTES + kt * (16 * KP * 2); vaddr[i] = 2 * KT_BYTES + slot * VT_BYTES + kt * (16 * VP * 2);
            krel[i] = dummy ? 100000 : (isp ? 16 * kt - 128 : 16 * kt);
        }
        const LAS unsigned char* klane = lds + ((lane & 15) * KP + 8 * quad) * 2;
        f32x4 s[9];
#pragma unroll
        for (int i = 0; i < 9; ++i) {
            s[i] = (f32x4){0.f, 0.f, 0.f, 0.f};
#pragma unroll
            for (int ks = 0; ks < 4; ++ks) s[i] = __builtin_amdgcn_mfma_f32_16x16x32_bf16(*(const LAS bf16x8*)(klane + kaddr[i] + 64 * ks), qf[ks], s[i], 0, 0, 0);
        }
        const float sc = 0.08838834764831845f * 1.4426950408889634f;
        float mx = -INFINITY;
#pragma unroll
        for (int i = 0; i < 9; ++i)
#pragma unroll
            for (int j = 0; j < 4; ++j) { const int rel = krel[i] + 4 * quad + j; const bool valid = (rel <= qq) && (rel >= qq - 128); const float t = valid ? s[i][j] * sc : -INFINITY; s[i][j] = t; mx = fmaxf(mx, t); }
        mx = fmaxf(mx, lane_xor16(mx, lane)); mx = fmaxf(mx, lane_xor32(mx, lane));
        float l = 0.f;
#pragma unroll
        for (int i = 0; i < 9; ++i)
#pragma unroll
            for (int j = 0; j < 4; ++j) { const float p = __builtin_amdgcn_exp2f(s[i][j] - mx); s[i][j] = p; l += p; }
        l += lane_xor16(l, lane); l += lane_xor32(l, lane);
        f32x4 o[8];
#pragma unroll
        for (int dt = 0; dt < 8; ++dt) o[dt] = (f32x4){0.f, 0.f, 0.f, 0.f};
        {
            const int tq = (lane & 15) >> 2, tp = lane & 3; const LAS unsigned char* vlane = lds + ((4 * quad + tq) * VP + 4 * tp) * 2;
#pragma unroll
            for (int m = 0; m < 5; ++m) {
                const int ia = 2 * m, ib = (m < 4) ? 2 * m + 1 : 8;
                v4u w; w.x = cvt_pk_bf16(s[ia][0], s[ia][1]); w.y = cvt_pk_bf16(s[ia][2], s[ia][3]);
                if (m < 4) { w.z = cvt_pk_bf16(s[ib][0], s[ib][1]); w.w = cvt_pk_bf16(s[ib][2], s[ib][3]); } else { w.z = 0u; w.w = 0u; }
                const bf16x8 pf = __builtin_bit_cast(bf16x8, w);
#pragma unroll
                for (int dt = 0; dt < 8; ++dt) {
                    const s16x4 lo = __builtin_amdgcn_ds_read_tr16_b64_v4i16((LAS s16x4*)(vlane + vaddr[ia] + 32 * dt));
                    const s16x4 hi = __builtin_amdgcn_ds_read_tr16_b64_v4i16((LAS s16x4*)(vlane + vaddr[ib] + 32 * dt));
                    bf16x8 av; av[0] = lo[0]; av[1] = lo[1]; av[2] = lo[2]; av[3] = lo[3]; av[4] = hi[0]; av[5] = hi[1]; av[6] = hi[2]; av[7] = hi[3];
                    o[dt] = __builtin_amdgcn_mfma_f32_16x16x32_bf16(av, pf, o[dt], 0, 0, 0);
                }
            }
        }
        {
            const int pq = (128 * cur.qt + qq) * cur.d + cur.r;
            const float inv = 1.f / l; const size_t row = (size_t)(cur.b << 11) + pq;
            bf16* op = OG + ((size_t)cur.g * MTOK + row) * 1024 + cur.h * 128 + 4 * quad;
#pragma unroll
            for (int dt = 0; dt < 8; ++dt) { v2u w; w.x = cvt_pk_bf16(o[dt][0] * inv, o[dt][1] * inv); w.y = cvt_pk_bf16(o[dt][2] * inv, o[dt][3] * inv); *(v2u*)(op + 16 * dt) = w; }
            if (quad == 0) LSE[((size_t)cur.g * MTOK + row) * 8 + cur.h] = (mx + __log2f(l)) * 0.6931471805599453f;
        }
        __syncthreads();
        if (has_next) {
            att_store_tile(lds + (par ^ 1) * KT_BYTES, lds + 2 * KT_BYTES + (par ^ 1) * VT_BYTES, tid, nkv, nvv);
#pragma unroll
            for (int ks = 0; ks < 4; ++ks) qf[ks] = nqf[ks];
            cur = nxt; cur_qt = __builtin_amdgcn_readfirstlane(cur.qt); par ^= 1;
        }
    }
    __syncthreads();
}

template <int W>
__device__ __forceinline__ void pool_run(const bf16* zc, bf16* pc, int t0) {
    v4u v[W + 7];
#pragma unroll
    for (int k = 0; k < W + 7; ++k) { const int dr = k - (W - 1); v[k] = (t0 + dr >= 0) ? *(const v4u*)(zc + (ptrdiff_t)dr * ZGP) : (v4u){0u, 0u, 0u, 0u}; }
    float S[8];
#pragma unroll
    for (int e = 0; e < 8; ++e) S[e] = 0.f;
#pragma unroll
    for (int k = 0; k < W - 1; ++k) { S[0] += bflo(v[k].x); S[1] += bfhi(v[k].x); S[2] += bflo(v[k].y); S[3] += bfhi(v[k].y); S[4] += bflo(v[k].z); S[5] += bfhi(v[k].z); S[6] += bflo(v[k].w); S[7] += bfhi(v[k].w); }
#pragma unroll
    for (int i = 0; i < 8; ++i) {
        const v4u c = v[W - 1 + i];
        const float a0 = bflo(c.x), a1 = bfhi(c.x), a2 = bflo(c.y), a3 = bfhi(c.y), a4 = bflo(c.z), a5 = bfhi(c.z), a6 = bflo(c.w), a7 = bfhi(c.w);
        S[0] += a0; S[1] += a1; S[2] += a2; S[3] += a3; S[4] += a4; S[5] += a5; S[6] += a6; S[7] += a7;
        const int cnt = (t0 + i + 1 < W) ? (t0 + i + 1) : W; const float ic = 1.f / (float)cnt;
        v4u o; o.x = cvt_pk_bf16(S[0] * ic - a0, S[1] * ic - a1); o.y = cvt_pk_bf16(S[2] * ic - a2, S[3] * ic - a3); o.z = cvt_pk_bf16(S[4] * ic - a4, S[5] * ic - a5); o.w = cvt_pk_bf16(S[6] * ic - a6, S[7] * ic - a7);
        *(v4u*)(pc + (size_t)i * 1024) = o;
        const v4u d = v[i];
        S[0] -= bflo(d.x); S[1] -= bfhi(d.x); S[2] -= bflo(d.y); S[3] -= bfhi(d.y); S[4] -= bflo(d.z); S[5] -= bfhi(d.z); S[6] -= bflo(d.w); S[7] -= bfhi(d.w);
    }
}

constexpr int SP = 272;
constexpr int SGU_STAT_OFF = 128 * SP * 2;
__device__ __forceinline__ void sgu_unit(LAS unsigned char* lds, const bf16* Z1, const float* VPART, const bf16* SGW, const float* ng, const float* nb, const float* sbias, bf16* MIX, int unit, int tid, int lane, int wave) {
    const int chunk = unit >> 2, h = unit & 3;
    const size_t row0 = (size_t)chunk * 128;
    LAS bf16* Vn = (LAS bf16*)lds; LAS float* st = (LAS float*)(lds + SGU_STAT_OFF);
    if (tid < 128) {
        const f32x4* pp = (const f32x4*)(VPART + (row0 + tid) * 32);
        float s1 = 0.f, s2 = 0.f;
#pragma unroll
        for (int q = 0; q < 8; ++q) { const f32x4 a = pp[q]; s1 += a.x + a.z; s2 += a.y + a.w; }
        const float mu = s1 * (1.f / 1024.f); const float var = fmaxf(s2 * (1.f / 1024.f) - mu * mu, 0.f);
        st[tid] = mu; st[128 + tid] = 1.f / sqrtf(var + EPS);
    }
    __syncthreads();
    {
        const int tl = tid >> 5, ch = tid & 31;
        const f32x4 g0 = *(const f32x4*)(ng + h * 256 + 8 * ch), g1 = *(const f32x4*)(ng + h * 256 + 8 * ch + 4), b0 = *(const f32x4*)(nb + h * 256 + 8 * ch), b1 = *(const f32x4*)(nb + h * 256 + 8 * ch + 4);
        v4u a[8];
#pragma unroll
        for (int ps = 0; ps < 8; ++ps) a[ps] = *(const v4u*)(Z1 + (row0 + 16 * ps + tl) * O2 + OC_V + h * 256 + 8 * ch);
#pragma unroll
        for (int ps = 0; ps < 8; ++ps) {
            const int j = 16 * ps + tl; const float mu = st[j], rs = st[128 + j];
            v4u w;
            w.x = cvt_pk_bf16((bflo(a[ps].x) - mu) * rs * g0[0] + b0[0], (bfhi(a[ps].x) - mu) * rs * g0[1] + b0[1]);
            w.y = cvt_pk_bf16((bflo(a[ps].y) - mu) * rs * g0[2] + b0[2], (bfhi(a[ps].y) - mu) * rs * g0[3] + b0[3]);
            w.z = cvt_pk_bf16((bflo(a[ps].z) - mu) * rs * g1[0] + b1[0], (bfhi(a[ps].z) - mu) * rs * g1[1] + b1[1]);
            w.w = cvt_pk_bf16((bflo(a[ps].w) - mu) * rs * g1[2] + b1[2], (bfhi(a[ps].w) - mu) * rs * g1[3] + b1[3]);
            *(LAS v4u*)(Vn + j * SP + 8 * ch) = w;
        }
    }
    const int fr = lane & 15, quad = lane >> 4;
    const int ti = 16 * wave + fr;
    bf16x8 wf[4];
    {
        const bf16* wp = SGW + ((size_t)h * 128 + ti) * 128 + 4 * quad;
#pragma unroll
        for (int ks = 0; ks < 4; ++ks) { const v2u lo = *(const v2u*)(wp + 32 * ks), hi = *(const v2u*)(wp + 32 * ks + 16); v4u w; w.x = lo.x; w.y = lo.y; w.z = hi.x; w.w = hi.y; wf[ks] = __builtin_bit_cast(bf16x8, w); }
    }
    __syncthreads();
    v2u uu[16];
    {
        const bf16* up = Z1 + (row0 + ti) * O2 + OC_UG + h * 256 + 4 * quad;
#pragma unroll
        for (int ct = 0; ct < 16; ++ct) uu[ct] = *(const v2u*)(up + 16 * ct);
    }
    f32x4 acc[16];
#pragma unroll
    for (int ct = 0; ct < 16; ++ct) acc[ct] = (f32x4){0.f, 0.f, 0.f, 0.f};
    const int nks = (wave >> 1) + 1;
    {
        const int tq = fr >> 2, tp = lane & 3;
        const LAS bf16* vbase = Vn + (4 * quad + tq) * SP + 4 * tp;
#pragma unroll
        for (int ks = 0; ks < 4; ++ks) {
            if (ks < nks) {
#pragma unroll
                for (int ct = 0; ct < 16; ++ct) {
                    const LAS bf16* vp = vbase + (32 * ks) * SP + 16 * ct;
                    const s16x4 lo = __builtin_amdgcn_ds_read_tr16_b64_v4i16((LAS s16x4*)vp);
                    const s16x4 hi = __builtin_amdgcn_ds_read_tr16_b64_v4i16((LAS s16x4*)(vp + 16 * SP));
                    bf16x8 av; av[0] = lo[0]; av[1] = lo[1]; av[2] = lo[2]; av[3] = lo[3]; av[4] = hi[0]; av[5] = hi[1]; av[6] = hi[2]; av[7] = hi[3];
                    acc[ct] = __builtin_amdgcn_mfma_f32_16x16x32_bf16(av, wf[ks], acc[ct], 0, 0, 0);
                }
            }
        }
    }
    {
        const float bias = sbias[h * 128 + ti];
        const size_t row = row0 + ti;
        bf16* op = MIX + row * DM + h * 256 + 4 * quad;
#pragma unroll
        for (int ct = 0; ct < 16; ++ct) {
            const v2u u = uu[ct];
            v2u w;
            w.x = cvt_pk_bf16(bflo(u.x) * (acc[ct][0] + bias), bfhi(u.x) * (acc[ct][1] + bias));
            w.y = cvt_pk_bf16(bflo(u.y) * (acc[ct][2] + bias), bfhi(u.y) * (acc[ct][3] + bias));
            *(v2u*)(op + 16 * ct) = w;
        }
    }
    __syncthreads();
}

constexpr int CONV_T = 32, CONV_ROWS = CONV_T + 30;
constexpr int CONV_RED_OFF = CONV_ROWS * 1024 * 2;
static_assert(CONV_RED_OFF + 32 * 8 * 4 + 32 * 4 <= LDS_BYTES, "conv LDS");
__device__ __forceinline__ void conv_unit(LAS unsigned char* lds, const bf16* Z1, const float* cw, const float* cb, const float* lg, const float* lb, bf16* MIX, int unit, int tid, int lane, int wave) {
    const size_t row0 = (size_t)unit * CONV_T;
    const int pos0 = (int)(row0 % SEQ);
    LAS unsigned* Dt = (LAS unsigned*)lds;
    LAS float* red = (LAS float*)(lds + CONV_RED_OFF); LAS float* stat = red + 32 * 8;
#pragma unroll 1
    for (int i0 = 0; i0 < 16; i0 += 8) {
        v4u a[8];
#pragma unroll
        for (int i = 0; i < 8; ++i) {
            const int idx = tid + (i0 + i) * NTHREADS; const int rr = idx >> 7, cbk = idx & 127;
            a[i] = (v4u){0u, 0u, 0u, 0u};
            if (rr < CONV_ROWS && pos0 + rr - 30 >= 0) a[i] = *(const v4u*)(Z1 + (row0 + rr - 30) * O2 + OC_DD + 8 * cbk);
        }
#pragma unroll
        for (int i = 0; i < 8; ++i) { const int idx = tid + (i0 + i) * NTHREADS; const int rr = idx >> 7, cbk = idx & 127; if (rr < CONV_ROWS) *(LAS v4u*)(Dt + rr * 512 + 4 * cbk) = a[i]; }
    }
    asm volatile("" ::: "memory");
    f32x2 wk[31];
#pragma unroll
    for (int k = 0; k < 31; ++k) wk[k] = *(const f32x2*)(cw + k * 1024 + 2 * tid);
    const f32x2 bias = *(const f32x2*)(cb + 2 * tid);
    __syncthreads();
    const f32x2 gg = *(const f32x2*)(lg + 2 * tid), bb = *(const f32x2*)(lb + 2 * tid);
#pragma unroll 1
    for (int hb = 0; hb < CONV_T; hb += 16) {
        f32x2 y[16];
#pragma unroll
        for (int t = 0; t < 16; ++t) {
            f32x2 a2 = bias;
#pragma unroll
            for (int k = 0; k < 31; ++k) { const unsigned v = Dt[(hb + t + k) * 512 + tid]; f32x2 in; in.x = bflo(v); in.y = bfhi(v); a2 = __builtin_elementwise_fma(wk[k], in, a2); }
            y[t] = a2;
        }
#pragma unroll
        for (int t = 0; t < 16; ++t) { const float sm = wave_sum(y[t].x + y[t].y); if (lane == 0) red[t * 8 + wave] = sm; }
        __syncthreads();
        if (tid < 16) { float sm = 0.f;
#pragma unroll
            for (int w = 0; w < 8; ++w) sm += red[tid * 8 + w];
            stat[tid] = sm * (1.f / 1024.f); }
        __syncthreads();
#pragma unroll
        for (int t = 0; t < 16; ++t) { const float mu = stat[t]; y[t].x -= mu; y[t].y -= mu; }
#pragma unroll
        for (int t = 0; t < 16; ++t) { const float sq = wave_sum(y[t].x * y[t].x + y[t].y * y[t].y); if (lane == 0) red[t * 8 + wave] = sq; }
        __syncthreads();
        if (tid < 16) { float sq = 0.f;
#pragma unroll
            for (int w = 0; w < 8; ++w) sq += red[tid * 8 + w];
            stat[16 + tid] = 1.f / sqrtf(sq * (1.f / 1024.f) + EPS); }
        __syncthreads();
        unsigned gtl[16];
#pragma unroll
        for (int t = 0; t < 16; ++t) gtl[t] = *(const unsigned*)(Z1 + (row0 + hb + t) * O2 + OC_DG + 2 * tid);
#pragma unroll
        for (int t = 0; t < 16; ++t) {
            const float rs = stat[16 + t];
            const unsigned gtv = gtl[t];
            const float v0 = silu_f(y[t].x * rs * gg.x + bb.x) * bflo(gtv), v1 = silu_f(y[t].y * rs * gg.y + bb.y) * bfhi(gtv);
            *(unsigned*)(MIX + (row0 + hb + t) * DM + 1024 + 2 * tid) = cvt_pk_bf16(v0, v1);
        }
        __syncthreads();
    }
}

struct Args { const float* in[19]; float* out; unsigned char* ws; int ph_lo, ph_hi; };

__global__ void __launch_bounds__(NTHREADS, 2) mega_fwd(Args args) {
    extern __shared__ __attribute__((aligned(16))) unsigned char lds_raw[];
    LAS unsigned char* lds = (LAS unsigned char*)lds_raw;
    {
        if (threadIdx.x < 4) ((LAS unsigned*)(lds + LDS_BYTES - 16))[threadIdx.x] = 0u;
        __syncthreads();
    }
    const XcdBarrier gbar = xcd_barrier_post((unsigned*)args.ws, (volatile LAS unsigned*)(lds + LDS_BYTES - 16));
    const int G = gridDim.x, bid = blockIdx.x;
    const int NGW = G * NWAVES, NGT = G * NTHREADS;
#define FRESH_IDS() int tid = threadIdx.x; asm volatile("" : "+v"(tid)); const int lane = tid & 63, wave = __builtin_amdgcn_readfirstlane(tid >> 6); \
    const int gw = bid * NWAVES + wave, gt = bid * NTHREADS + tid; (void)lane; (void)gw; (void)gt;
#define WSP(T, off) ((T*)(args.ws + (off)))
#define INP(k) (args.in[k])
    const int lo = args.ph_lo, hi = args.ph_hi;
#define IN(k) (lo <= (k) && (k) < hi)
#define SEAM(k) do { if (IN(k) && IN((k) + 1)) { xcd_barrier(gbar); for (int xs_ = 0; xs_ < XSYNC; ++xs_) xcd_barrier(gbar); } } while (0)

    if (IN(0)) for (int rep_ = 0; rep_ < REP0; ++rep_) {
        FRESH_IDS();
        const float* x = INP(0); const float* e_pre = INP(1); const float* e_w_in = INP(2); const float* e_pool_w = INP(3); const float* e_w_out = INP(5);
        const float* o_w_in = INP(8); const float* o_sgu_w = INP(11); const float* o_w_out = INP(17); const float* o_pre = INP(7);
        bf16* W1 = WSP(bf16, WS_W1); bf16* W2 = WSP(bf16, WS_W2); bf16* W3 = WSP(bf16, WS_W3); bf16* W4 = WSP(bf16, WS_W4);
        bf16* PW = WSP(bf16, WS_PW); bf16* SGW = WSP(bf16, WS_SGW); float* ROPE = WSP(float, WS_ROPE);
        LAS float* scr = (LAS float*)(lds + wave * 17408);
        constexpr int I1 = (DM / 64) * (EIN / 32), I2 = (DM / 64) * (DM / 32), I3 = (DM / 64) * (OIN / 32), I4 = I2, IPG = (256 / 64) * (256 / 32), IP = 4 * IPG;
        constexpr int NIT = I1 + I2 + I3 + I4 + IP;
        auto mk = [&](int it) -> TrItem {
            const float* W; bf16* WT; int K, N, r = it, ro = 0; bool perm3 = false;
            if (r < I1) { W = e_w_in; WT = W1; K = DM; N = EIN; }
            else if ((r -= I1) < I2) { W = e_w_out; WT = W2; K = DM; N = DM; }
            else if ((r -= I2) < I3) { W = o_w_in; WT = W3; K = DM; N = OIN; perm3 = true; }
            else if ((r -= I3) < I4) { W = o_w_out; WT = W4; K = DM; N = DM; }
            else { r -= I4; const int pg = r / IPG; r -= pg * IPG; W = e_pool_w + (size_t)pg * 65536; WT = PW; K = 256; N = 256; ro = pg * 256; }
            const int nblk = N / 32, kb = r / nblk, nb = r % nblk;
            int drow = ro + 32 * nb;
            if (perm3) {
                const int c = 32 * nb, seg = c >> 10, cc = c & 1023, tt = cc >> 7, j = cc & 127;
                drow = seg == 0 ? 256 * tt + j : seg == 1 ? 2048 + cc : seg == 2 ? 256 * tt + 128 + j : seg == 3 ? 3072 + 256 * tt + j : seg == 4 ? 3072 + 256 * tt + 128 + j : 5120 + cc;
            }
            TrItem t; t.src = W + (size_t)(64 * kb) * N + 32 * nb; t.dst = WT + (size_t)drow * K + 64 * kb; t.N = N; t.K = K; t.gk = perm3 ? o_pre + 64 * kb : (WT == W1 ? e_pre + 64 * kb : nullptr); return t;
        };
        for (int it = gw; it < NIT; it += 2 * NGW) {
            const bool two = (it + NGW) < NIT;
            const TrItem t0 = mk(it), t1 = mk(two ? it + NGW : it);
            float v0[32], v1[32];
            p0_tr_load(t0, v0, lane); p0_tr_load(t1, v1, lane);
            p0_tr_store(t0, v0, scr, lane);
            if (two) p0_tr_store(t1, v1, scr + 64 * 33, lane);
        }
        { bf16* XB = WSP(bf16, WS_XB); float* R0 = WSP(float, WS_R0);
          for (int m = 2 * gw; m < MTOK; m += 2 * NGW) rows2_to_bf16_rms(x + (size_t)m * DM, x + (size_t)(m + 1) * DM, XB + (size_t)m * DM, XB + (size_t)(m + 1) * DM, R0 + m, R0 + m + 1, lane); }
        for (int i = gt; i < 4 * 128 * 128; i += NGT) { const int jj = i & 127, ii = (i >> 7) & 127; const float v = (jj <= ii) ? o_sgu_w[i] : 0.f; SGW[i] = (bf16)(cvt_pk_bf16(v, 0.f) & 0xffffu); }
        for (int i = gt; i < SEQ * 16; i += NGT) {
            const int p = i >> 4, f = i & 15;
            double rr = sqrt(sqrt(sqrt(sqrt(1.0 / 500000.0)))); double inv = 1.0;
            for (int e = 0; e < f; ++e) inv *= rr;
            const float ang = (float)p * (float)inv;
            const double xa = (double)ang; const double n = rint(xa * 0.15915494309189535); const float red = (float)(xa - n * 6.283185307179586);
            ROPE[p * 32 + f] = cosf(red); ROPE[p * 32 + 16 + f] = sinf(red);
        }
    }
    SEAM(0);
    if (IN(1)) for (int rep_ = 0; rep_ < REP1; ++rep_) {
        pg8::Gemm g{WSP(bf16, WS_XB), WSP(bf16, WS_W1), MTOK, EIN, DM, DM, DM, 0}; pg8::StaticOrder S; S.init(MTOK, EIN, G, bid);
        pg8::EpiBf16 E{WSP(bf16, WS_ZG), ZGP, WSP(float, WS_ROPE), 8, 32, WSP(bf16, WS_Q), WSP(float, WS_R0), 4, 44};
        pg8::gemm_phase<pg8::EpiBf16, true>(lds, g, S, E);
    }
    SEAM(1);
    if (IN(2)) for (int rep_ = 0; rep_ < REP2; ++rep_) {
        FRESH_IDS();
        const bf16* Z = WSP(bf16, WS_ZG); const bf16* QB = WSP(bf16, WS_Q); bf16* POOLED = WSP(bf16, WS_POOLED);
#ifndef NO_ATTN
        attn_phase(lds, QB, WSP(bf16, WS_OG), WSP(float, WS_LSE), (int)((long)bid * 1536 / G), (int)((long)(bid + 1) * 1536 / G), tid, lane, wave);
#endif
        for (int wv = gw; wv < 2048; wv += NGW) {
            const int grp = wv & 3, run = (wv >> 2) * 2 + (lane >> 5), c = grp * 256 + (lane & 31) * 8, row = run * 8;
            const bf16* zc = Z + (size_t)row * ZGP + ZG_AIN + c; bf16* pc = POOLED + (size_t)row * 1024 + c; const int t0 = row & (SEQ - 1);
            if (grp == 0) pool_run<2>(zc, pc, t0); else if (grp == 1) pool_run<4>(zc, pc, t0); else if (grp == 2) pool_run<8>(zc, pc, t0); else pool_run<16>(zc, pc, t0);
        }
    }
    SEAM(2);
    if (IN(3)) for (int rep_ = 0; rep_ < REP3; ++rep_) {
        {
            pg8::Gemm g{WSP(bf16, WS_POOLED), WSP(bf16, WS_PW), MTOK, 1024, 256, 1024, 256, 512}; pg8::StaticOrder S; S.init(MTOK, 1024, G, bid);
            pg8::EpiPool E{WSP(bf16, WS_MIX), DM, WSP(bf16, WS_ZG) + ZG_AGATE, ZGP, INP(4)};
            pg8::gemm_phase<pg8::EpiPool, true>(lds, g, S, E);
        }
        FRESH_IDS();
        const bf16* Z = WSP(bf16, WS_ZG); const bf16* OG = WSP(bf16, WS_OG); const float* LSE = WSP(float, WS_LSE); bf16* MIX = WSP(bf16, WS_MIX);
        const int mfirst = (G > 128) ? 128 : 0, mcus = G - mfirst;
        const int gtm = (bid - mfirst) * NTHREADS + tid, NGTM = mcus * NTHREADS;
        if (bid >= mfirst)
#pragma unroll 1
        for (int i0 = gtm; i0 < MTOK * 128; i0 += 4 * NGTM) {
            v4u a[4], b[4], d[4], gv[4]; float l0[4], l1[4], l2[4];
#pragma unroll
            for (int q = 0; q < 4; ++q) {
                int i = i0 + q * NGTM; if (i >= MTOK * 128) i = gtm;
                const int row = i >> 7, c = (i & 127) * 8, h = c >> 7;
                l0[q] = LSE[(size_t)row * 8 + h]; l1[q] = LSE[((size_t)MTOK + row) * 8 + h]; l2[q] = LSE[((size_t)2 * MTOK + row) * 8 + h];
                a[q] = *(const v4u*)(OG + (size_t)row * 1024 + c); b[q] = *(const v4u*)(OG + ((size_t)MTOK + row) * 1024 + c); d[q] = *(const v4u*)(OG + ((size_t)2 * MTOK + row) * 1024 + c);
                gv[q] = *(const v4u*)(Z + (size_t)row * ZGP + ZG_BGATE + c);
            }
#pragma unroll
            for (int q = 0; q < 4; ++q) {
                const int i = i0 + q * NGTM; if (i >= MTOK * 128) continue;
                const int row = i >> 7, c = (i & 127) * 8;
                const float m = fmaxf(l0[q], fmaxf(l1[q], l2[q]));
                float w0 = __expf(l0[q] - m), w1 = __expf(l1[q] - m), w2 = __expf(l2[q] - m); const float inv = 1.f / (w0 + w1 + w2); w0 *= inv; w1 *= inv; w2 *= inv;
                v4u o;
                o.x = cvt_pk_bf16((w0 * bflo(a[q].x) + w1 * bflo(b[q].x) + w2 * bflo(d[q].x)) * bflo(gv[q].x), (w0 * bfhi(a[q].x) + w1 * bfhi(b[q].x) + w2 * bfhi(d[q].x)) * bfhi(gv[q].x));
                o.y = cvt_pk_bf16((w0 * bflo(a[q].y) + w1 * bflo(b[q].y) + w2 * bflo(d[q].y)) * bflo(gv[q].y), (w0 * bfhi(a[q].y) + w1 * bfhi(b[q].y) + w2 * bfhi(d[q].y)) * bfhi(gv[q].y));
                o.z = cvt_pk_bf16((w0 * bflo(a[q].z) + w1 * bflo(b[q].z) + w2 * bflo(d[q].z)) * bflo(gv[q].z), (w0 * bfhi(a[q].z) + w1 * bfhi(b[q].z) + w2 * bfhi(d[q].z)) * bfhi(gv[q].z));
                o.w = cvt_pk_bf16((w0 * bflo(a[q].w) + w1 * bflo(b[q].w) + w2 * bflo(d[q].w)) * bflo(gv[q].w), (w0 * bfhi(a[q].w) + w1 * bfhi(b[q].w) + w2 * bfhi(d[q].w)) * bfhi(gv[q].w));
                *(v4u*)(MIX + (size_t)row * DM + 1024 + c) = o;
            }
        }
    }
    SEAM(3);
    if (IN(4)) for (int rep_ = 0; rep_ < REP4; ++rep_) {
        pg8::Gemm g{WSP(bf16, WS_MIX), WSP(bf16, WS_W2), MTOK, DM, DM, DM, DM, 0}; pg8::StaticOrder S; S.init(MTOK, DM, G, bid);
        if (G == 256) {
            EpiMid E{WSP(bf16, WS_XB), WSP(bf16, WS_X1B), INP(6), WSP(float, WS_SS), WSP(float, WS_SS2), gbar};
            pg8::gemm_phase<EpiMid, false>(lds, g, S, E);
        } else {
            pg8::EpiBf16 E{WSP(bf16, WS_Y), DM, nullptr, 0, 0, nullptr, nullptr, -8, -8};
            pg8::gemm_phase<pg8::EpiBf16, false>(lds, g, S, E);
        }
    }
    if (G != 256) SEAM(4);
    if (IN(5) && G != 256) for (int rep_ = 0; rep_ < REP5; ++rep_) {
        FRESH_IDS();
        const bf16* XB = WSP(bf16, WS_XB); const float* e_post = INP(6); const bf16* Y = WSP(bf16, WS_Y); bf16* X1B = WSP(bf16, WS_X1B); float* R1 = WSP(float, WS_R1);
        for (int m0 = 2 * gw; m0 < MTOK; m0 += 2 * NGW) {
            f32x4 v[2][8], xv[2][8];
#pragma unroll
            for (int q = 0; q < 2; ++q) {
                const v4u* yr = (const v4u*)(Y + (size_t)(m0 + q) * DM) + lane; const v4u* xr = (const v4u*)(XB + (size_t)(m0 + q) * DM) + lane;
#pragma unroll
                for (int j = 0; j < 4; ++j) { const v4u y = yr[64 * j]; v[q][2 * j] = (f32x4){bflo(y.x), bfhi(y.x), bflo(y.y), bfhi(y.y)}; v[q][2 * j + 1] = (f32x4){bflo(y.z), bfhi(y.z), bflo(y.w), bfhi(y.w)}; }
#pragma unroll
                for (int j = 0; j < 4; ++j) { const v4u y = xr[64 * j]; xv[q][2 * j] = (f32x4){bflo(y.x), bfhi(y.x), bflo(y.y), bfhi(y.y)}; xv[q][2 * j + 1] = (f32x4){bflo(y.z), bfhi(y.z), bflo(y.w), bfhi(y.w)}; }
            }
            float s[2] = {0.f, 0.f};
#pragma unroll
            for (int q = 0; q < 2; ++q)
#pragma unroll
                for (int j = 0; j < 8; ++j) s[q] += (v[q][j].x * v[q][j].x + v[q][j].y * v[q][j].y) + (v[q][j].z * v[q][j].z + v[q][j].w * v[q][j].w);
#pragma unroll
            for (int q = 0; q < 2; ++q) s[q] = wave_sum(s[q]);
            float s1[2] = {0.f, 0.f};
#pragma unroll
            for (int q = 0; q < 2; ++q) { const float r = 1.f / sqrtf(s[q] * (1.f / DM) + EPS);
#pragma unroll
                for (int j = 0; j < 8; ++j) { const f32x4 gg = ((const f32x4*)e_post)[128 * (j >> 1) + 2 * lane + (j & 1)]; v[q][j] = xv[q][j] + v[q][j] * r * gg; s1[q] += (v[q][j].x * v[q][j].x + v[q][j].y * v[q][j].y) + (v[q][j].z * v[q][j].z + v[q][j].w * v[q][j].w); } }
#pragma unroll
            for (int q = 0; q < 2; ++q) s1[q] = wave_sum(s1[q]);
#pragma unroll
            for (int q = 0; q < 2; ++q) {
                if (lane == 0) R1[m0 + q] = 1.f / sqrtf(s1[q] * (1.f / DM) + EPS);
                v4u* o8 = (v4u*)(X1B + (size_t)(m0 + q) * DM) + lane;
#pragma unroll
                for (int j = 0; j < 4; ++j) { const f32x4 a = v[q][2 * j], b = v[q][2 * j + 1];
                    v4u w; w.x = cvt_pk_bf16(a.x, a.y); w.y = cvt_pk_bf16(a.z, a.w); w.z = cvt_pk_bf16(b.x, b.y); w.w = cvt_pk_bf16(b.z, b.w); o8[64 * j] = w; } }
        }
    }
    SEAM(5);
    if (IN(6)) for (int rep_ = 0; rep_ < REP6; ++rep_) {
        pg8::Gemm g{WSP(bf16, WS_X1B), WSP(bf16, WS_W3), MTOK, OIN, DM, DM, DM, 0}; pg8::StaticOrder S; S.init(MTOK, OIN, G, bid);
        pg8::EpiOdd E{WSP(bf16, WS_Z1), O2, WSP(float, WS_VPART), (G == 256) ? WSP(float, WS_SS2) : (float*)nullptr, WSP(float, WS_R1)};
        pg8::gemm_phase<pg8::EpiOdd, true>(lds, g, S, E);
    }
    SEAM(6);
    if (IN(7)) for (int rep_ = 0; rep_ < REP7; ++rep_) {
        FRESH_IDS();
        const bf16* Z1 = WSP(bf16, WS_Z1); bf16* MIX = WSP(bf16, WS_MIX);
#ifndef NO_SGU
        for (int u = bid; u < 256; u += G) sgu_unit(lds, Z1, WSP(float, WS_VPART), WSP(bf16, WS_SGW), INP(9), INP(10), INP(12), MIX, u, tid, lane, wave);
#endif
        asm volatile("" ::: "memory");
#ifndef NO_CONV
        for (int u = bid; u < 256; u += G) conv_unit(lds, Z1, INP(13), INP(14), INP(15), INP(16), MIX, u, tid, lane, wave);
#endif
    }
    SEAM(7);
    if (IN(8)) for (int rep_ = 0; rep_ < REP8; ++rep_) {
        pg8::Gemm g{WSP(bf16, WS_MIX), WSP(bf16, WS_W4), MTOK, DM, DM, DM, DM, 0}; pg8::StaticOrder S; S.init(MTOK, DM, G, bid);
        if (G == 256) {
            EpiFinal E{WSP(bf16, WS_X1B), args.out, INP(18), WSP(float, WS_SS), gbar};
            pg8::gemm_phase<EpiFinal, false>(lds, g, S, E);
        } else {
            pg8::EpiBf16 E{WSP(bf16, WS_Y), DM, nullptr, 0, 0, nullptr, nullptr, -8, -8};
            pg8::gemm_phase<pg8::EpiBf16, false>(lds, g, S, E);
        }
    }
    if (G != 256) SEAM(8);
    if (IN(9) && G != 256) {
        FRESH_IDS();
        const float* o_post = INP(18); const bf16* Y = WSP(bf16, WS_Y); const bf16* X1B = WSP(bf16, WS_X1B); float* out = args.out;
        for (int m0 = 2 * gw; m0 < MTOK; m0 += 2 * NGW) {
            f32x4 v[2][8], xv[2][8];
#pragma unroll
            for (int q = 0; q < 2; ++q) {
                const v4u* yr = (const v4u*)(Y + (size_t)(m0 + q) * DM) + lane; const v4u* xr = (const v4u*)(X1B + (size_t)(m0 + q) * DM) + lane;
#pragma unroll
                for (int j = 0; j < 4; ++j) { const v4u y = yr[64 * j]; v[q][2 * j] = (f32x4){bflo(y.x), bfhi(y.x), bflo(y.y), bfhi(y.y)}; v[q][2 * j + 1] = (f32x4){bflo(y.z), bfhi(y.z), bflo(y.w), bfhi(y.w)}; }
#pragma unroll
                for (int j = 0; j < 4; ++j) { const v4u y = xr[64 * j]; xv[q][2 * j] = (f32x4){bflo(y.x), bfhi(y.x), bflo(y.y), bfhi(y.y)}; xv[q][2 * j + 1] = (f32x4){bflo(y.z), bfhi(y.z), bflo(y.w), bfhi(y.w)}; }
            }
            float s[2] = {0.f, 0.f};
#pragma unroll
            for (int q = 0; q < 2; ++q)
#pragma unroll
                for (int j = 0; j < 8; ++j) s[q] += (v[q][j].x * v[q][j].x + v[q][j].y * v[q][j].y) + (v[q][j].z * v[q][j].z + v[q][j].w * v[q][j].w);
#pragma unroll
            for (int q = 0; q < 2; ++q) s[q] = wave_sum(s[q]);
#pragma unroll
            for (int q = 0; q < 2; ++q) { const float r = 1.f / sqrtf(s[q] * (1.f / DM) + EPS); f32x4* orow = (f32x4*)(out + (size_t)(m0 + q) * DM) + 2 * lane;
#pragma unroll
                for (int j = 0; j < 8; ++j) { const f32x4 gg = ((const f32x4*)o_post)[128 * (j >> 1) + 2 * lane + (j & 1)]; orow[128 * (j >> 1) + (j & 1)] = xv[q][j] + v[q][j] * r * gg; } }
        }
    }
#ifdef EXTRA_PH
    if (IN(10)) { FRESH_IDS(); const bf16* Z = WSP(bf16, WS_Q); attn_phase(lds, Z, WSP(bf16, WS_OG), WSP(float, WS_LSE), (int)((long)bid * 1536 / G), (int)((long)(bid + 1) * 1536 / G), tid, lane, wave); }
    if (IN(12)) { FRESH_IDS(); for (int u = bid; u < 256; u += G) sgu_unit(lds, WSP(bf16, WS_Z1), WSP(float, WS_VPART), WSP(bf16, WS_SGW), INP(9), INP(10), INP(12), WSP(bf16, WS_MIX), u, tid, lane, wave); }
    if (IN(13)) { FRESH_IDS(); for (int u = bid; u < 256; u += G) conv_unit(lds, WSP(bf16, WS_Z1), INP(13), INP(14), INP(15), INP(16), WSP(bf16, WS_MIX), u, tid, lane, wave); }
#endif
#undef IN
#undef SEAM
}

extern "C" void kernel_launch(void* const* d_in, const int* in_sizes, int n_in, void* d_out, int out_size, void* d_ws, size_t ws_size, hipStream_t stream) {
    static int grid = 0;
    if (grid == 0) {
        if (n_in != 19 || out_size != MTOK * DM || ws_size < WS_END) { fprintf(stderr, "kernel_launch: unexpected shapes (n_in %d, out %d, ws %zu)\n", n_in, out_size, ws_size); grid = -1; return; }
        int dev = 0, cus = 0, per_cu = 0;
        if (hipGetDevice(&dev) != hipSuccess || hipDeviceGetAttribute(&cus, hipDeviceAttributeMultiprocessorCount, dev) != hipSuccess) { grid = -1; return; }
        if (hipFuncSetAttribute((const void*)mega_fwd, hipFuncAttributeMaxDynamicSharedMemorySize, LDS_BYTES) != hipSuccess) { fprintf(stderr, "kernel_launch: hipFuncSetAttribute failed\n"); grid = -1; return; }
        if (hipOccupancyMaxActiveBlocksPerMultiprocessor(&per_cu, (const void*)mega_fwd, NTHREADS, LDS_BYTES) != hipSuccess || per_cu < 1) { fprintf(stderr, "kernel_launch: occupancy query gave %d\n", per_cu); per_cu = 1; }
        (void)hipGetLastError();
        grid = cus * per_cu;
    }
    if (grid < 0) return;
    Args a{};
    for (int i = 0; i < 19; ++i) a.in[i] = (const float*)d_in[i];
    a.out = (float*)d_out; a.ws = (unsigned char*)d_ws;
#if MK_N_LAUNCHES == 1
    a.ph_lo = 0; a.ph_hi = 10;
    (void)hipMemsetAsync(d_ws, 0, 16384, stream);
    hipLaunchKernelGGL(mega_fwd, dim3(grid), dim3(NTHREADS), LDS_BYTES, stream, a);
#ifdef EXTRA_PH
    for (int i = 0; i < EXTRA_N; ++i) { Args b = a; b.ph_lo = EXTRA_PH; b.ph_hi = EXTRA_PH + 1; hipLaunchKernelGGL(mega_fwd, dim3(grid), dim3(NTHREADS), LDS_BYTES, stream, b); }
#endif
#else
    for (int p = 0; p < 10; ++p) { a.ph_lo = p; a.ph_hi = p + 1; hipLaunchKernelGGL(mega_fwd, dim3(grid), dim3(NTHREADS), LDS_BYTES, stream, a); }
#endif
}
```
